# Optimizing an MI355X kernel written in HIP

```python
import jax, jax.numpy as jnp
from jax import lax
import numpy as np

D_MODEL = 1024
BATCH = 16
SEQ = 2048
DEPTH = 1

CONV_WIDTH = D_MODEL
CONV_KERNEL = 31
GLA_HEADS = 4
GLA_KEY_DIM = D_MODEL // 2
GLA_VAL_DIM = D_MODEL
GLA_DK = GLA_KEY_DIM // GLA_HEADS
GLA_DV = GLA_VAL_DIM // GLA_HEADS
GATE_RANK = 16
GATE_TEMP = 16.0
CHUNK = 64
EPS = 1e-6

IN_SIZES = (CONV_WIDTH, CONV_WIDTH, CONV_WIDTH,
            GLA_KEY_DIM, GLA_KEY_DIM, GLA_VAL_DIM, GATE_RANK, GLA_VAL_DIM,
            D_MODEL, D_MODEL)
IN_SPLITS = tuple(int(s) for s in np.cumsum(IN_SIZES)[:-1])
IN_WIDTH = int(sum(IN_SIZES))

kernel_name = "hybrid_conformer_conv_gla_gated_merge"


def rms_norm(x, g):
    xf = x.astype(jnp.float32)
    y = xf * lax.rsqrt(jnp.mean(xf * xf, axis=-1, keepdims=True) + EPS)
    return (y * g.astype(jnp.float32)).astype(x.dtype)


def layer_norm(x, g, b):
    xf = x.astype(jnp.float32)
    mu = jnp.mean(xf, axis=-1, keepdims=True)
    xc = xf - mu
    y = xc * lax.rsqrt(jnp.mean(xc * xc, axis=-1, keepdims=True) + EPS)
    return (y * g.astype(jnp.float32) + b.astype(jnp.float32)).astype(x.dtype)


def conformer_conv_branch(u_val, u_gate, z, conv_w, conv_b, ln_g, ln_b, w_proj):
    u = u_val * jax.nn.sigmoid(u_gate)
    u = lax.conv_general_dilated(
        u, conv_w[:, None, :].astype(u.dtype),
        window_strides=(1,), padding=[(CONV_KERNEL - 1, 0)],
        dimension_numbers=('NWC', 'WIO', 'NWC'),
        feature_group_count=CONV_WIDTH) + conv_b
    u = jax.nn.silu(layer_norm(u, ln_g, ln_b))
    u = u * jax.nn.silu(z)
    return u @ w_proj


def gla_chunked(q, k, v, log_a):
    B, S, H, DK = q.shape
    DV = v.shape[-1]
    N = S // CHUNK
    f32 = jnp.float32
    q = (q.astype(f32) * (DK ** -0.5)).reshape(B, N, CHUNK, H, DK)
    k = k.astype(f32).reshape(B, N, CHUNK, H, DK)
    v = v.astype(f32).reshape(B, N, CHUNK, H, DV)
    b = jnp.cumsum(log_a.astype(f32).reshape(B, N, CHUNK, H, DK), axis=2)
    b_last = b[:, :, -1]
    ref = b[:, :, CHUNK // 2 - 1:CHUNK // 2]
    scores = jnp.einsum('bnihd,bnjhd->bnhij', q * jnp.exp(b - ref), k * jnp.exp(ref - b))
    causal = jnp.tril(jnp.ones((CHUNK, CHUNK), dtype=bool))
    scores = jnp.where(causal, scores, 0.0)
    o_intra = jnp.einsum('bnhij,bnjhv->bnihv', scores, v)
    kv = jnp.einsum('bnjhd,bnjhv->bnhdv', k * jnp.exp(b_last[:, :, None] - b), v)
    decay = jnp.exp(b_last)

    def step(state, inp):
        dec, kv_n = inp
        return dec[..., None] * state + kv_n, state

    _, s_prev = lax.scan(step, jnp.zeros((B, H, DK, DV), f32),
                         (jnp.moveaxis(decay, 1, 0), jnp.moveaxis(kv, 1, 0)))
    s_prev = jnp.moveaxis(s_prev, 0, 1)
    o_inter = jnp.einsum('bnihd,bnhdv->bnihv', q * jnp.exp(b), s_prev)
    return (o_intra + o_inter).reshape(B, S, H, DV)


def setup_inputs(seed: int = 0) -> dict:
    key = jax.random.key(seed)
    ks = jax.random.split(key, 16)
    f32 = jnp.float32
    nrm = lambda k, shape, scale: jax.random.normal(k, shape, f32) * scale
    L = DEPTH
    return {
        "x": jax.random.normal(ks[0], (BATCH, SEQ, D_MODEL), f32),
        "norm_g": 1.0 + nrm(ks[1], (L, D_MODEL), 0.02),
        "w_in": nrm(ks[2], (L, D_MODEL, IN_WIDTH), D_MODEL ** -0.5),
        "conv_w": nrm(ks[3], (L, CONV_KERNEL, CONV_WIDTH), CONV_KERNEL ** -0.5),
        "conv_b": nrm(ks[4], (L, CONV_WIDTH), 0.02),
        "conv_ln_g": 1.0 + nrm(ks[5], (L, CONV_WIDTH), 0.02),
        "conv_ln_b": nrm(ks[6], (L, CONV_WIDTH), 0.02),
        "w_conv_out": nrm(ks[7], (L, CONV_WIDTH, D_MODEL), CONV_WIDTH ** -0.5),
        "gate_w2": nrm(ks[8], (L, GATE_RANK, GLA_KEY_DIM), GATE_RANK ** -0.5),
        "gate_b": nrm(ks[9], (L, GLA_KEY_DIM), 0.1),
        "gla_norm_g": 1.0 + nrm(ks[10], (L, GLA_DV), 0.02),
        "w_gla_out": nrm(ks[11], (L, GLA_VAL_DIM, D_MODEL), GLA_VAL_DIM ** -0.5),
        "w_out": nrm(ks[12], (L, D_MODEL, D_MODEL), D_MODEL ** -0.5),
        "final_g": 1.0 + nrm(ks[13], (D_MODEL,), 0.02),
    }


def reference(x, norm_g, w_in, conv_w, conv_b, conv_ln_g, conv_ln_b, w_conv_out,
              gate_w2, gate_b, gla_norm_g, w_gla_out, w_out, final_g):
    B, S, _ = x.shape
    for l in range(DEPTH):
        h = rms_norm(x, norm_g[l])
        proj = h @ w_in[l]
        (c_val, c_gate, c_z, q, k, v, g_lr, g_r, m_conv, m_gla) = jnp.split(proj, IN_SPLITS, axis=-1)

        y_conv = conformer_conv_branch(c_val, c_gate, c_z, conv_w[l], conv_b[l],
                                       conv_ln_g[l], conv_ln_b[l], w_conv_out[l])

        z = (g_lr @ gate_w2[l] + gate_b[l]).astype(jnp.float32)
        log_a = jax.nn.log_sigmoid(z) / GATE_TEMP
        o = gla_chunked(q.reshape(B, S, GLA_HEADS, GLA_DK),
                        k.reshape(B, S, GLA_HEADS, GLA_DK),
                        v.reshape(B, S, GLA_HEADS, GLA_DV),
                        log_a.reshape(B, S, GLA_HEADS, GLA_DK))
        o = rms_norm(o, gla_norm_g[l]).astype(x.dtype).reshape(B, S, GLA_VAL_DIM)
        y_gla = (o * jax.nn.silu(g_r)) @ w_gla_out[l]

        y = jax.nn.sigmoid(m_conv) * y_conv + jax.nn.sigmoid(m_gla) * y_gla
        x = x + y @ w_out[l]
    return rms_norm(x, final_g)
```

```cpp
#include <hip/hip_runtime.h>
#include <hip/hip_cooperative_groups.h>
#include <cstdio>
#include <cstdint>
namespace cg = cooperative_groups;
namespace pg8 {
#define PG8_LAS __attribute__((address_space(3)))
typedef unsigned short bf16_t;
typedef short bf16x8 __attribute__((ext_vector_type(8)));
typedef float f32x4 __attribute__((ext_vector_type(4)));
typedef unsigned u32x4 __attribute__((ext_vector_type(4)));
constexpr int BM = 256, BK = 64, HALF = 128, HTB = HALF * BK * 2  , STAGE_BYTES = 8 * HTB, NXCD = 8, WGM = 4;

__host__ __device__ __forceinline__ int lds_byte(int r, int c) { const int st = (r >> 4) * 2 + (c >> 5), rr = r & 15, cc = c & 31, ob = rr * 64 + cc * 2; return st * 1024 + (ob ^ (((ob >> 9) & 1) << 5)); }
__host__ __device__ __forceinline__ void stage_rc(int b, int& R, int& C) { const int st = b / 1024, sb = b % 1024, swz = sb ^ (((sb >> 9) & 1) << 5); R = (st >> 1) * 16 + swz / 64; C = (st & 1) * 32 + (swz % 64) / 2; }
__host__ __device__ __forceinline__ int perm32(int rho) { const int n = rho >> 4, i = rho & 15; return 8 * (i >> 2) + 4 * n + (i & 3); }

struct Unit { int pm, pn; };
struct Gemm { const bf16_t* A; const bf16_t* Bt; int M, N, K; };

struct StaticOrder {
    int nM, nN, nwg, G, c;
    __host__ __device__ void init(int M, int N, int G_, int c_) { nM = M / BM; nN = N / BM; nwg = nM * nN; G = G_; c = c_; }
    __host__ __device__ bool next(int i, Unit& u) const {
        const long L = (long)i * G + c; if (L >= nwg) return false;
        int wgid = (int)L; { const int q = nwg / NXCD, r = nwg % NXCD, xcd = wgid % NXCD, off = wgid / NXCD; wgid = (xcd < r ? xcd * (q + 1) : r * (q + 1) + (xcd - r) * q) + off; }
        const int nig = WGM * nN, gid = wgid / nig, fm = gid * WGM, gsz = (nM - fm) < WGM ? (nM - fm) : WGM;
        u.pm = fm + ((wgid % nig) % gsz); u.pn = (wgid % nig) / gsz; return true;
    }
    __device__ __forceinline__ void a_ready(const Unit&) const {}
    __device__ __forceinline__ void done(const Unit&) const {}
};
__device__ __forceinline__ unsigned cvt_pk_bf16(float lo, float hi) { unsigned r; asm volatile("v_cvt_pk_bf16_f32 %0, %1, %2" : "=v"(r) : "v"(lo), "v"(hi)); return r; }
typedef float f32x2 __attribute__((ext_vector_type(2)));
template <class Epi, class Sched, bool ALIGN_EPI = false, bool SP2 = false>
__device__ __forceinline__ void gemm_phase(PG8_LAS unsigned char* lds, const Gemm g, const Sched& S, const Epi& E) {
    const int tid = threadIdx.x, wid = __builtin_amdgcn_readfirstlane(tid >> 6), lane = tid & 63, wr = wid >> 2, wc = wid & 3, fr = lane & 15, fq = lane >> 4;
    const int K = g.K, nt = K / BK;
    unsigned voffA[2], voffB[2];
#pragma unroll
    for (int i = 0; i < 2; ++i) { int R, C; stage_rc(tid * 16 + i * 8192, R, C); const int Rb = Epi::PERM ? ((R & ~31) + perm32(R & 31)) : R;
        voffA[i] = (unsigned)(R * K + C) * 2u; voffB[i] = (unsigned)(Rb * K + C) * 2u; }
    const size_t kstep = (size_t)(BK * 2);
    const size_t hstep = (size_t)HALF * K * 2;
    const size_t tstep = 2 * hstep;
    const unsigned ldsw = (unsigned)wid * 1024u;
    const int aoff = lds_byte(wr * 64 + fr, fq * 8), boff = lds_byte(wc * 32 + fr, fq * 8);
#define PG8_SA(b, h) (((b) * 2 + (h)) * HTB)
#define PG8_SB(b, h) ((4 + (b) * 2 + (h)) * HTB)
#define PG8_STAGE(bufoff, gbase, voff) do { _Pragma("unroll") for (int _i = 0; _i < 2; ++_i) \
        __builtin_amdgcn_global_load_lds((const unsigned*)((const char*)(gbase) + (voff)[_i]), (PG8_LAS unsigned*)(lds + (bufoff) + ldsw + _i * 8192), 16, 0, 0); } while (0)
#define PG8_LDA(dst, b, h) do { _Pragma("unroll") for (int m = 0; m < 4; ++m) _Pragma("unroll") for (int k = 0; k < 2; ++k) dst[m][k] = *(const PG8_LAS bf16x8*)(lds + PG8_SA(b, h) + aoff + m * 2048 + k * 1024); } while (0)
#define PG8_LDB(dst, b, h) do { _Pragma("unroll") for (int n = 0; n < 2; ++n) _Pragma("unroll") for (int k = 0; k < 2; ++k) dst[n][k] = *(const PG8_LAS bf16x8*)(lds + PG8_SB(b, h) + boff + n * 2048 + k * 1024); } while (0)
#define PG8_MMA(ai, bj, At, Bt) do { __builtin_amdgcn_s_setprio(1); _Pragma("unroll") for (int m = 0; m < 4; ++m) _Pragma("unroll") for (int n = 0; n < 2; ++n) _Pragma("unroll") for (int k = 0; k < 2; ++k) \
        acc[ai][bj][m][n] = __builtin_amdgcn_mfma_f32_16x16x32_bf16(Bt[n][k], At[m][k], acc[ai][bj][m][n], 0, 0, 0); __builtin_amdgcn_s_setprio(0); } while (0)
#define PG8_WAIT_V(n) asm volatile("s_waitcnt vmcnt(" #n ")" ::: "memory")
#define PG8_WAIT_L(n) asm volatile("s_waitcnt lgkmcnt(" #n ")" ::: "memory")
#define PG8_BAR __builtin_amdgcn_s_barrier()
#define PG8_SCHED __builtin_amdgcn_sched_barrier(0)
    Unit cur, nxt; int ui = 0;
    if (!S.next(0, cur)) return;
    f32x4 acc[2][2][4][2];
#pragma unroll
    for (int a = 0; a < 2; ++a)
#pragma unroll
        for (int b = 0; b < 2; ++b)
#pragma unroll
            for (int m = 0; m < 4; ++m)
#pragma unroll
                for (int n = 0; n < 2; ++n) acc[a][b][m][n] = (f32x4){0.f, 0.f, 0.f, 0.f};
    bf16x8 At[4][2], B0[2][2], B1[2][2];
    const char* cA = (const char*)g.A + (size_t)cur.pm * tstep; const char* cB = (const char*)g.Bt + (size_t)cur.pn * tstep;
    S.a_ready(cur);
    if constexpr (SP2) {
        PG8_STAGE(PG8_SB(0, 0), cB, voffB); PG8_STAGE(PG8_SB(0, 1), cB + hstep, voffB); PG8_STAGE(PG8_SA(0, 0), cA, voffA); PG8_STAGE(PG8_SA(0, 1), cA + hstep, voffA);
        if (wr == 1) PG8_BAR;
        PG8_WAIT_V(2); PG8_BAR;
        PG8_STAGE(PG8_SB(1, 0), cB + kstep, voffB); PG8_STAGE(PG8_SA(1, 0), cA + kstep, voffA); PG8_STAGE(PG8_SB(1, 1), cB + hstep + kstep, voffB);
        PG8_WAIT_V(6); PG8_BAR;
    } else {
        PG8_STAGE(PG8_SB(0, 0), cB, voffB); PG8_STAGE(PG8_SA(0, 0), cA, voffA); PG8_STAGE(PG8_SB(0, 1), cB + hstep, voffB); PG8_STAGE(PG8_SA(0, 1), cA + hstep, voffA);
        if (wr == 1) PG8_BAR;
        PG8_WAIT_V(4); PG8_BAR;
        PG8_STAGE(PG8_SB(1, 0), cB + kstep, voffB); PG8_STAGE(PG8_SA(1, 0), cA + kstep, voffA); PG8_STAGE(PG8_SB(1, 1), cB + hstep + kstep, voffB);
        PG8_WAIT_V(6); PG8_BAR;
    }
    for (;;) {
        const bool has_next = S.next(ui + 1, nxt);
        const char* nA = has_next ? (const char*)g.A + (size_t)nxt.pm * tstep : cA; const char* nB = has_next ? (const char*)g.Bt + (size_t)nxt.pn * tstep : cB;
        for (int t = 0; t < nt; t += 2) {
            const bool last = (t == nt - 2);
            const char* a1 = cA + (size_t)(t + 1) * kstep;
            const char* a2 = last ? nA : cA + (size_t)(t + 2) * kstep; const char* b2 = last ? nB : cB + (size_t)(t + 2) * kstep;
            const char* a3 = a2 + kstep; const char* b3 = b2 + kstep;
            if (last && has_next) S.a_ready(nxt);
            if constexpr (SP2) {
            PG8_LDB(B0, 0, 0); PG8_LDB(B1, 0, 1); PG8_SCHED; PG8_LDA(At, 0, 0); PG8_STAGE(PG8_SA(1, 1), a1 + hstep, voffA);
            PG8_WAIT_V(8); PG8_WAIT_L(0); PG8_BAR; PG8_MMA(0, 0, At, B0); PG8_MMA(0, 1, At, B1); PG8_BAR; PG8_SCHED;
            PG8_LDA(At, 0, 1); PG8_STAGE(PG8_SB(0, 0), b2, voffB); PG8_STAGE(PG8_SB(0, 1), b2 + hstep, voffB); PG8_STAGE(PG8_SA(0, 0), a2, voffA);
            PG8_WAIT_V(8); PG8_WAIT_L(0); PG8_BAR; PG8_MMA(1, 0, At, B0); PG8_MMA(1, 1, At, B1); PG8_BAR; PG8_SCHED;
            PG8_LDB(B0, 1, 0); PG8_LDB(B1, 1, 1); PG8_SCHED; PG8_LDA(At, 1, 0); PG8_STAGE(PG8_SA(0, 1), a2 + hstep, voffA);
            PG8_WAIT_V(8); PG8_WAIT_L(0); PG8_BAR; PG8_MMA(0, 0, At, B0); PG8_MMA(0, 1, At, B1); PG8_BAR; PG8_SCHED;
            PG8_LDA(At, 1, 1); PG8_STAGE(PG8_SB(1, 0), b3, voffB); PG8_STAGE(PG8_SB(1, 1), b3 + hstep, voffB); PG8_STAGE(PG8_SA(1, 0), a3, voffA);
            PG8_WAIT_V(8); PG8_WAIT_L(0); PG8_BAR; PG8_MMA(1, 0, At, B0); PG8_MMA(1, 1, At, B1); PG8_BAR; PG8_SCHED;
            } else {
            PG8_LDB(B0, 0, 0); PG8_SCHED; PG8_LDA(At, 0, 0); PG8_STAGE(PG8_SA(1, 1), a1 + hstep, voffA);
            PG8_WAIT_L(8); PG8_BAR; PG8_WAIT_L(0); PG8_MMA(0, 0, At, B0); PG8_BAR; PG8_SCHED;
            PG8_LDB(B1, 0, 1); PG8_STAGE(PG8_SB(0, 0), b2, voffB);
            PG8_BAR; PG8_WAIT_L(0); PG8_MMA(0, 1, At, B1); PG8_BAR;
            PG8_LDA(At, 0, 1); PG8_STAGE(PG8_SA(0, 0), a2, voffA);
            PG8_BAR; PG8_WAIT_L(0); PG8_MMA(1, 0, At, B0); PG8_BAR; PG8_SCHED;
            PG8_STAGE(PG8_SB(0, 1), b2 + hstep, voffB);
            PG8_WAIT_V(6); PG8_BAR; PG8_MMA(1, 1, At, B1); PG8_BAR;
            PG8_LDB(B0, 1, 0); PG8_SCHED; PG8_LDA(At, 1, 0); PG8_STAGE(PG8_SA(0, 1), a2 + hstep, voffA);
            PG8_WAIT_L(8); PG8_BAR; PG8_WAIT_L(0); PG8_MMA(0, 0, At, B0); PG8_BAR; PG8_SCHED;
            PG8_LDB(B1, 1, 1); PG8_STAGE(PG8_SB(1, 0), b3, voffB);
            PG8_BAR; PG8_WAIT_L(0); PG8_MMA(0, 1, At, B1); PG8_BAR;
            PG8_LDA(At, 1, 1); PG8_STAGE(PG8_SA(1, 0), a3, voffA);
            PG8_BAR; PG8_WAIT_L(0); PG8_MMA(1, 0, At, B0); PG8_BAR; PG8_SCHED;
            PG8_STAGE(PG8_SB(1, 1), b3 + hstep, voffB);
            PG8_WAIT_V(6); PG8_BAR; PG8_MMA(1, 1, At, B1); PG8_BAR;
            }
        }
        if constexpr (ALIGN_EPI) { if (wr == 0) PG8_BAR; }
        if constexpr (!Epi::AFTER_DRAIN) { E(acc, cur, wr, wc, fr, fq); S.done(cur); }
        if (!has_next) break;
#pragma unroll
        for (int a = 0; a < 2; ++a)
#pragma unroll
            for (int b = 0; b < 2; ++b)
#pragma unroll
                for (int m = 0; m < 4; ++m)
#pragma unroll
                    for (int n = 0; n < 2; ++n) acc[a][b][m][n] = (f32x4){0.f, 0.f, 0.f, 0.f};
        cur = nxt; cA = nA; cB = nB; ++ui;
        if constexpr (ALIGN_EPI) { if (wr == 1) PG8_BAR; }
    }
    PG8_WAIT_V(0);
    if constexpr (!ALIGN_EPI) { if (wr == 0) PG8_BAR; }
    PG8_BAR;
    if constexpr (Epi::AFTER_DRAIN) { E.fused(acc, cur, wr, wc, fr, fq, lds, wid, lane); S.done(cur); }
#undef PG8_SA
#undef PG8_SB
#undef PG8_STAGE
#undef PG8_LDA
#undef PG8_LDB
#undef PG8_MMA
#undef PG8_WAIT_V
#undef PG8_WAIT_L
#undef PG8_BAR
#undef PG8_SCHED
}
}

#ifndef MK_N_LAUNCHES
#define MK_N_LAUNCHES 1
#endif
#ifdef DUMP_SRC
#define MK_DUMP 1
#else
#define MK_DUMP 0
#endif
#ifndef PG8_SP2
#define PG8_SP2 true
#endif
#ifndef PG8_ALIGN
#define PG8_ALIGN true
#endif

constexpr int D = 1024, BATCH = 16, SEQ = 2048, M = BATCH * SEQ;
constexpr int INW = 8208, NPROJ = 8192;
constexpr int CONVK = 31, NH = 4, DK = 128, DV = 256, KD = 512, RANK = 16, CHUNK = 64, NCHUNK = SEQ / CHUNK;
constexpr float EPS = 1e-6f;
constexpr int NWAVES = 8, NT = NWAVES * 64;

constexpr size_t MiB = 1u << 20;
constexpr size_t WS_WIN = 1 * MiB, WS_WCO = 17 * MiB, WS_WGO = 19 * MiB, WS_WO = 21 * MiB;
constexpr size_t WS_GLR = 23 * MiB;
constexpr size_t WS_SSQP = 25 * MiB;
constexpr size_t WS_ROWSS = 29 * MiB;
constexpr size_t WS_CTL = 0, CTL_ZERO_BYTES = 131072;
constexpr size_t WS_CNT = 65536;
constexpr size_t WS_SZ = 32 * MiB;
constexpr size_t WS_Q = 96 * MiB;
constexpr size_t WS_K = 128 * MiB;
constexpr size_t WS_V = 160 * MiB;
constexpr size_t WS_SGR = 224 * MiB;
constexpr size_t WS_MC = 288 * MiB;
constexpr size_t WS_MG = 352 * MiB;
constexpr size_t WS_PP = 416 * MiB, WS_PQB = 432 * MiB, WS_PKLT = 464 * MiB, WS_PDEC = 496 * MiB;
constexpr size_t WS_END = 497 * MiB;

constexpr int LDS_BYTES = 147456;
constexpr int LDS_MISC = 147200;

#define LAS __attribute__((address_space(3)))
typedef unsigned short bf16;
typedef float f32x4 __attribute__((ext_vector_type(4)));
typedef float f32x2 __attribute__((ext_vector_type(2)));
typedef short bf16x8 __attribute__((ext_vector_type(8)));
typedef unsigned u32x4 __attribute__((ext_vector_type(4)));
typedef unsigned u32x2 __attribute__((ext_vector_type(2)));

__device__ __forceinline__ float bf2f(unsigned b) { return __uint_as_float(b << 16); }
__device__ __forceinline__ float bflo(unsigned w) { return __uint_as_float(w << 16); }
__device__ __forceinline__ float bfhi(unsigned w) { return __uint_as_float(w & 0xffff0000u); }
typedef __bf16 bf16v2 __attribute__((ext_vector_type(2)));
__device__ __forceinline__ unsigned pk2(float lo, float hi) { return pg8::cvt_pk_bf16(lo, hi); }
__device__ __forceinline__ unsigned short f2bf(float f) { return __builtin_bit_cast(unsigned short, (__bf16)f); }
__device__ __forceinline__ float sigm(float x) { return __builtin_amdgcn_rcpf(1.0f + __expf(-x)); }
#define LDS_BARRIER() do { asm volatile("s_waitcnt lgkmcnt(0)" ::: "memory"); __builtin_amdgcn_s_barrier(); asm volatile("" ::: "memory"); } while (0)
__device__ __forceinline__ float wave_sum(float v) {
#pragma unroll
    for (int o = 1; o < 64; o <<= 1) v += __shfl_xor(v, o);
    return v;
}
__device__ __forceinline__ float reduce16(const float (&v)[16], int lane) {
    float a[8], b[4], c[2], d;
    const bool h5 = lane & 32, h4 = lane & 16, h3 = lane & 8, h2 = lane & 4;
#pragma unroll
    for (int i = 0; i < 8; ++i) { const float mine = h5 ? v[8 + i] : v[i], theirs = h5 ? v[i] : v[8 + i]; a[i] = mine + __shfl_xor(theirs, 32); }
#pragma unroll
    for (int i = 0; i < 4; ++i) { const float mine = h4 ? a[4 + i] : a[i], theirs = h4 ? a[i] : a[4 + i]; b[i] = mine + __shfl_xor(theirs, 16); }
#pragma unroll
    for (int i = 0; i < 2; ++i) { const float mine = h3 ? b[2 + i] : b[i], theirs = h3 ? b[i] : b[2 + i]; c[i] = mine + __shfl_xor(theirs, 8); }
    { const float mine = h2 ? c[1] : c[0], theirs = h2 ? c[0] : c[1]; d = mine + __shfl_xor(theirs, 4); }
    d += __shfl_xor(d, 2); d += __shfl_xor(d, 1);
    return d;
}

__device__ __forceinline__ float reduce8(const float (&v)[8], int lane) {
    float a[4], b[2], c;
    const bool h5 = lane & 32, h4 = lane & 16, h3 = lane & 8;
#pragma unroll
    for (int i = 0; i < 4; ++i) { const float mine = h5 ? v[4 + i] : v[i], theirs = h5 ? v[i] : v[4 + i]; a[i] = mine + __shfl_xor(theirs, 32); }
#pragma unroll
    for (int i = 0; i < 2; ++i) { const float mine = h4 ? a[2 + i] : a[i], theirs = h4 ? a[i] : a[2 + i]; b[i] = mine + __shfl_xor(theirs, 16); }
    { const float mine = h3 ? b[1] : b[0], theirs = h3 ? b[0] : b[1]; c = mine + __shfl_xor(theirs, 8); }
    c += __shfl_xor(c, 4); c += __shfl_xor(c, 2); c += __shfl_xor(c, 1);
    return c;
}

struct EpiProj {
    static constexpr bool PERM = true, AFTER_DRAIN = false;
    bf16* U; unsigned char* ws;
    __device__ __forceinline__ void operator()(const f32x4 (&acc)[2][2][4][2], const pg8::Unit& u, int wr, int wc, int fr, int fq) const {
        const int row0 = u.pm * 256 + wr * 64 + fr, pn = u.pn, cw = wc * 32 + 8 * fq;
        if (pn < 8) {
            bf16* base = U + (size_t)row0 * 1024 + pn * 128 + cw;
#pragma unroll
            for (int ai = 0; ai < 2; ++ai)
#pragma unroll
                for (int m = 0; m < 4; ++m) {
                    f32x4 a0 = acc[ai][0][m][0], a1 = acc[ai][0][m][1]; const f32x4 g0 = acc[ai][1][m][0], g1 = acc[ai][1][m][1];
#pragma unroll
                    for (int e = 0; e < 4; ++e) { a0[e] *= sigm(g0[e]); a1[e] *= sigm(g1[e]); }
                    u32x4 w; w.x = pk2(a0[0], a0[1]); w.y = pk2(a0[2], a0[3]); w.z = pk2(a1[0], a1[1]); w.w = pk2(a1[2], a1[3]);
                    __builtin_nontemporal_store(w, (u32x4*)(base + (size_t)(ai * 128 + m * 16) * 1024)); }
        } else {
            size_t boff; int ld, colt, mode; float sc = 1.f;
            if (pn < 12)      { boff = WS_SZ;  ld = 1024; colt = (pn - 8) * 256;  mode = 0; }
            else if (pn < 14) { boff = WS_Q;   ld = 512;  colt = (pn - 12) * 256; mode = 0; sc = 0.08838834764831845f; }
            else if (pn < 16) { boff = WS_K;   ld = 512;  colt = (pn - 14) * 256; mode = 0; }
            else if (pn < 20) { boff = WS_V;   ld = 1024; colt = (pn - 16) * 256; mode = 0; }
            else if (pn < 24) { boff = WS_SGR; ld = 1024; colt = (pn - 20) * 256; mode = 0; }
            else if (pn < 28) { boff = WS_MC;  ld = 1024; colt = (pn - 24) * 256; mode = 2; }
            else              { boff = WS_MG;  ld = 1024; colt = (pn - 28) * 256; mode = 2; }
            bf16* base = (bf16*)(ws + boff);
            base += (size_t)row0 * ld + colt + cw;
#pragma unroll
            for (int ai = 0; ai < 2; ++ai)
#pragma unroll
                for (int m = 0; m < 4; ++m)
#pragma unroll
                    for (int bj = 0; bj < 2; ++bj) {
                        f32x4 v0 = acc[ai][bj][m][0], v1 = acc[ai][bj][m][1];
                        if (mode == 0) { v0 = v0 * sc; v1 = v1 * sc; }
                        else {
#pragma unroll
                            for (int e = 0; e < 4; ++e) { const float s0 = sigm(v0[e]), s1 = sigm(v1[e]); v0[e] = (mode == 1) ? v0[e] * s0 : s0; v1[e] = (mode == 1) ? v1[e] * s1 : s1; }
                        }
                        u32x4 w; w.x = pk2(v0[0], v0[1]); w.y = pk2(v0[2], v0[3]); w.z = pk2(v1[0], v1[1]); w.w = pk2(v1[2], v1[3]);
                        __builtin_nontemporal_store(w, (u32x4*)(base + (size_t)(ai * 128 + m * 16) * ld + bj * 128)); }
        }
    }
};
struct EpiMul {
    static constexpr bool PERM = true, AFTER_DRAIN = false;
    bf16* O; const bf16* G;
    __device__ __forceinline__ void operator()(const f32x4 (&acc)[2][2][4][2], const pg8::Unit& u, int wr, int wc, int fr, int fq) const {
        const size_t off0 = (size_t)(u.pm * 256 + wr * 64 + fr) * 1024 + u.pn * 256 + wc * 32 + 8 * fq;
#pragma unroll
        for (int ai = 0; ai < 2; ++ai) {
            u32x4 gv[4][2];
#pragma unroll
            for (int m = 0; m < 4; ++m)
#pragma unroll
                for (int bj = 0; bj < 2; ++bj) gv[m][bj] = __builtin_nontemporal_load((const u32x4*)(G + off0 + (size_t)(ai * 128 + m * 16) * 1024 + bj * 128));
#pragma unroll
            for (int m = 0; m < 4; ++m)
#pragma unroll
                for (int bj = 0; bj < 2; ++bj) {
                    const size_t off = off0 + (size_t)(ai * 128 + m * 16) * 1024 + bj * 128;
                    const u32x4 g = gv[m][bj]; const f32x4 v0 = acc[ai][bj][m][0], v1 = acc[ai][bj][m][1];
                    u32x4 w; w.x = pk2(v0[0] * bflo(g.x), v0[1] * bfhi(g.x)); w.y = pk2(v0[2] * bflo(g.y), v0[3] * bfhi(g.y));
                    w.z = pk2(v1[0] * bflo(g.z), v1[1] * bfhi(g.z)); w.w = pk2(v1[2] * bflo(g.w), v1[3] * bfhi(g.w));
                    *(u32x4*)(O + off) = w; }
        }
    }
};
struct EpiMerge {
    static constexpr bool PERM = true, AFTER_DRAIN = false;
    bf16* O; const bf16* C; const bf16* G;
    __device__ __forceinline__ void operator()(const f32x4 (&acc)[2][2][4][2], const pg8::Unit& u, int wr, int wc, int fr, int fq) const {
        const size_t off0 = (size_t)(u.pm * 256 + wr * 64 + fr) * 1024 + u.pn * 256 + wc * 32 + 8 * fq;
#pragma unroll
        for (int ai = 0; ai < 2; ++ai) {
            u32x4 gv[4][2], cv[4][2];
#pragma unroll
            for (int m = 0; m < 4; ++m)
#pragma unroll
                for (int bj = 0; bj < 2; ++bj) { const size_t off = off0 + (size_t)(ai * 128 + m * 16) * 1024 + bj * 128; gv[m][bj] = __builtin_nontemporal_load((const u32x4*)(G + off)); cv[m][bj] = __builtin_nontemporal_load((const u32x4*)(C + off)); }
#pragma unroll
            for (int m = 0; m < 4; ++m)
#pragma unroll
                for (int bj = 0; bj < 2; ++bj) {
                    const size_t off = off0 + (size_t)(ai * 128 + m * 16) * 1024 + bj * 128;
                    const u32x4 g = gv[m][bj], c = cv[m][bj]; const f32x4 v0 = acc[ai][bj][m][0], v1 = acc[ai][bj][m][1];
                    u32x4 w; w.x = pk2(bflo(c.x) + v0[0] * bflo(g.x), bfhi(c.x) + v0[1] * bfhi(g.x)); w.y = pk2(bflo(c.y) + v0[2] * bflo(g.y), bfhi(c.y) + v0[3] * bfhi(g.y));
                    w.z = pk2(bflo(c.z) + v1[0] * bflo(g.z), bfhi(c.z) + v1[1] * bfhi(g.z)); w.w = pk2(bflo(c.w) + v1[2] * bflo(g.w), bfhi(c.w) + v1[3] * bfhi(g.w));
                    __builtin_nontemporal_store(w, (u32x4*)(O + off)); }
        }
    }
};
struct EpiRes {
    static constexpr bool PERM = false, AFTER_DRAIN = false;
    float* out; const float* X; float* SS;
    __device__ __forceinline__ void operator()(const f32x4 (&acc)[2][2][4][2], const pg8::Unit& u, int wr, int wc, int fr, int fq) const {
        const int row0 = u.pm * 256 + wr * 64 + fr, col0 = u.pn * 256 + wc * 32 + 4 * fq;
#pragma unroll
        for (int ai = 0; ai < 2; ++ai)
#pragma unroll
            for (int m = 0; m < 4; ++m) {
                const int row = row0 + ai * 128 + m * 16; const size_t off = (size_t)row * 1024 + col0; float s = 0.f;
#pragma unroll
                for (int bj = 0; bj < 2; ++bj)
#pragma unroll
                    for (int n = 0; n < 2; ++n) { const f32x4 r = *(const f32x4*)(X + off + bj * 128 + n * 16) + acc[ai][bj][m][n]; *(f32x4*)(out + off + bj * 128 + n * 16) = r;
                        s += (r[0] * r[0] + r[1] * r[1]) + (r[2] * r[2] + r[3] * r[3]); }
                s += __shfl_xor(s, 16); s += __shfl_xor(s, 32);
                if (fq == 0) SS[((size_t)u.pn * M + row) * 4 + wc] = s; }
    }
};

struct EpiBranches {
    static constexpr bool PERM = true, AFTER_DRAIN = false;
    bf16* Y; bf16* YCM; const bf16* MC; const bf16* MG;
    __device__ __forceinline__ void operator()(const f32x4 (&acc)[2][2][4][2], const pg8::Unit& u, int wr, int wc, int fr, int fq) const {
        if (u.pn < 4) { EpiMul e{YCM, MC}; e(acc, u, wr, wc, fr, fq); }
        else { pg8::Unit v; v.pm = u.pm - M / 256; v.pn = u.pn - 4; EpiMerge e{Y, YCM, MG}; e(acc, v, wr, wc, fr, fq); }
    }
};
struct BranchOrder {
    pg8::StaticOrder base; int nb;
    __device__ __forceinline__ void init(int G, int c) { base.init(M, D, G, c); nb = (base.nwg - c + G - 1) / G; }
    __device__ __forceinline__ bool next(int i, pg8::Unit& u) const { const int s = (i >= nb) ? 1 : 0, j = i - s * nb; if (j >= nb) return false; const bool ok = base.next(j, u); u.pm += s * (M / 256); u.pn += s * 4; return ok; }
    __device__ __forceinline__ void a_ready(const pg8::Unit&) const {}
    __device__ __forceinline__ void done(const pg8::Unit&) const {}
};

struct EpiResNorm {
    static constexpr bool PERM = false, AFTER_DRAIN = true;
    float* out; const float* X; const float* Gn; float* slots; unsigned* cnt;
    __device__ __forceinline__ void fused(f32x4 (&acc)[2][2][4][2], const pg8::Unit& u, int wr, int wc, int fr, int fq, PG8_LAS unsigned char* lds, int wid, int lane) const {
        PG8_LAS float* Pt = (PG8_LAS float*)lds;
        PG8_LAS float* St = (PG8_LAS float*)(lds + 4096);
        const int tid = wid * 64 + lane, col0 = u.pn * 256 + wc * 32 + 4 * fq;
#pragma unroll
        for (int ai = 0; ai < 2; ++ai)
#pragma unroll
            for (int m = 0; m < 4; ++m) {
                const int rl = ai * 128 + wr * 64 + m * 16 + fr; const size_t off = (size_t)(u.pm * 256 + rl) * 1024 + col0; float s = 0.f;
#pragma unroll
                for (int bj = 0; bj < 2; ++bj)
#pragma unroll
                    for (int n = 0; n < 2; ++n) { const f32x4 r = __builtin_nontemporal_load((const f32x4*)(X + off + bj * 128 + n * 16)) + acc[ai][bj][m][n]; acc[ai][bj][m][n] = r;
                        s += (r[0] * r[0] + r[1] * r[1]) + (r[2] * r[2] + r[3] * r[3]); }
                s += __shfl_xor(s, 16); s += __shfl_xor(s, 32);
                if (fq == 0) Pt[rl * 4 + wc] = s; }
        __syncthreads();
        if (tid < 256) { const f32x4 p = *(const PG8_LAS f32x4*)(Pt + tid * 4); __hip_atomic_store(slots + ((size_t)u.pm * 4 + u.pn) * 256 + tid, (p[0] + p[1]) + (p[2] + p[3]), __ATOMIC_RELAXED, __HIP_MEMORY_SCOPE_AGENT); }
        asm volatile("s_waitcnt vmcnt(0)" ::: "memory");
        __syncthreads();
        if (tid == 0) {
            unsigned* c = cnt + u.pm * 64;
            (void)__hip_atomic_fetch_add(c, 1u, __ATOMIC_RELAXED, __HIP_MEMORY_SCOPE_AGENT);
            unsigned spins = 0;
            while (__hip_atomic_load(c, __ATOMIC_RELAXED, __HIP_MEMORY_SCOPE_AGENT) < 4u) { __builtin_amdgcn_s_sleep(1); if (++spins > (1u << 24)) break; }
        }
        __syncthreads();
        if (tid < 256) { float ssq = 0.f;
#pragma unroll
            for (int q = 0; q < 4; ++q) ssq += __hip_atomic_load(slots + ((size_t)u.pm * 4 + q) * 256 + tid, __ATOMIC_RELAXED, __HIP_MEMORY_SCOPE_AGENT);
            St[tid] = 1.0f / sqrtf(ssq * (1.0f / 1024.0f) + 1e-6f); }
        __syncthreads();
#pragma unroll
        for (int ai = 0; ai < 2; ++ai)
#pragma unroll
            for (int m = 0; m < 4; ++m) {
                const int rl = ai * 128 + wr * 64 + m * 16 + fr; const size_t off = (size_t)(u.pm * 256 + rl) * 1024 + col0; const float rstd = St[rl];
#pragma unroll
                for (int bj = 0; bj < 2; ++bj)
#pragma unroll
                    for (int n = 0; n < 2; ++n) { const f32x4 g4 = *(const f32x4*)(Gn + col0 + bj * 128 + n * 16); __builtin_nontemporal_store(acc[ai][bj][m][n] * rstd * g4, (f32x4*)(out + off + bj * 128 + n * 16)); } }
        __syncthreads();
    }
};
struct HalfOrder : pg8::StaticOrder {
    int pmoff;
    __device__ __forceinline__ bool next(int i, pg8::Unit& u) const { const bool ok = pg8::StaticOrder::next(i, u); u.pm += pmoff; return ok; }
};

struct Args { const float* in[14]; float* out; unsigned char* ws; int ph_lo, ph_hi; };

__device__ __forceinline__ int srcmap(int n) {
    if (n < 2048) { const int pn = n >> 8, i = n & 255; return (i < 128) ? (128 * pn + i) : (1024 + 128 * pn + (i - 128)); }
    return (n < 5120) ? n : n + 16;
}
__device__ __forceinline__ void transpose_item(const float* W, int ldw, int src0, bf16* WT, int K, int dst0, int k0, LAS float* scr, int lane) {
#pragma unroll 8
    for (int i = 0; i < 32; ++i) { const int kk = 2 * i + (lane >> 5); scr[kk * 33 + (lane & 31)] = W[(size_t)(k0 + kk) * ldw + src0 + (lane & 31)]; }
    asm volatile("s_waitcnt lgkmcnt(0)" ::: "memory");
    const int c = lane & 7;
#pragma unroll
    for (int j = 0; j < 4; ++j) { const int n = (lane >> 3) + 8 * j; const LAS float* s = scr + (8 * c) * 33 + n;
        u32x4 o; o.x = pk2(s[0 * 33], s[1 * 33]); o.y = pk2(s[2 * 33], s[3 * 33]); o.z = pk2(s[4 * 33], s[5 * 33]); o.w = pk2(s[6 * 33], s[7 * 33]);
        *(u32x4*)(WT + (size_t)(dst0 + n) * K + k0 + 8 * c) = o; }
    asm volatile("s_waitcnt lgkmcnt(0)" ::: "memory");
}

#define XB_TMO      128
#define XB_XCNT(j)  (256  + 64 * (j))
#define XB_XSUB(j)  (1280 + 64 * (j))
#define XB_XGEN(j)  (2304 + 64 * (j))
#define XB_TOP      3328
#define XB_TOPGEN   3392
#define XCD_BAR_WORDS 3456
#define XB_SPIN_CAP (1u << 18)

__device__ __forceinline__ unsigned xb_ld(unsigned* p)              { return __hip_atomic_load(p, __ATOMIC_RELAXED, __HIP_MEMORY_SCOPE_AGENT); }
__device__ __forceinline__ unsigned xb_add(unsigned* p, unsigned v) { return __hip_atomic_fetch_add(p, v, __ATOMIC_RELAXED, __HIP_MEMORY_SCOPE_AGENT); }
__device__ __forceinline__ unsigned xb_xcc_id() { return (unsigned)__builtin_amdgcn_s_getreg((3 << 11) | 20) & 0xFu; }
#define XB_SPIN(cond, bar) do { unsigned _sp = 0; while (cond) { __builtin_amdgcn_s_sleep(1); \
    if ((++_sp & 255u) == 0u) { if (xb_ld(&(bar)[XB_TMO])) break; if (_sp > XB_SPIN_CAP) { atomicAdd(&(bar)[XB_TMO], 1u); break; } } } } while (0)

struct XcdBarrier {
    unsigned* bar; unsigned x;
    volatile LAS unsigned* st;
};

__device__ __forceinline__ XcdBarrier xcd_barrier_post(unsigned* bar, volatile LAS unsigned* st) {
    XcdBarrier b; b.bar = bar; b.x = xb_xcc_id(); b.st = st;
    if (threadIdx.x == 0) st[2] = xb_add(&bar[XB_XCNT(b.x)], 1u);
    return b;
}
__device__ __forceinline__ void xcd_barrier_complete(unsigned* bar, unsigned x, unsigned& nloc, unsigned& nx) {
    const unsigned G = gridDim.x * gridDim.y * gridDim.z;
    unsigned sum, cnt, mine, sp = 0u;
    for (;;) {
        sum = 0u; cnt = 0u; mine = 0u;
#pragma unroll
        for (unsigned j = 0; j < 16; ++j) { const unsigned c = xb_ld(&bar[XB_XCNT(j)]); sum += c; cnt += (c > 0u) ? 1u : 0u; mine = (j == x) ? c : mine; }
        if (sum == G) break;
        __builtin_amdgcn_s_sleep(1);
        if ((++sp & 255u) == 0u) { if (xb_ld(&bar[XB_TMO])) break; if (sp > XB_SPIN_CAP) { atomicAdd(&bar[XB_TMO], 1u); break; } }
    }
    nloc = mine > 0u ? mine : 1u; nx = cnt > 0u ? cnt : 1u;
}

__device__ __forceinline__ void xcd_barrier(const XcdBarrier& b) {
    asm volatile("s_waitcnt vmcnt(0)" ::: "memory");
    __syncthreads();
    if (threadIdx.x == 0) {
        unsigned* bar = b.bar;
        __builtin_amdgcn_s_waitcnt(0);
        unsigned nloc = b.st[0], nx = b.st[1];
        if (nloc == 0u) { xcd_barrier_complete(bar, b.x, nloc, nx); b.st[0] = nloc; b.st[1] = nx; }
        const unsigned old = xb_add(&bar[XB_XSUB(b.x)], 1u);
        const unsigned gen = old / nloc;
        if (old + 1u == (gen + 1u) * nloc) {
            __builtin_amdgcn_fence(__ATOMIC_RELEASE, "agent");
            asm volatile("s_waitcnt vmcnt(0)" ::: "memory");
            const unsigned og = xb_add(&bar[XB_TOP], 1u);
            const unsigned tg = og / nx;
            if (og + 1u == (tg + 1u) * nx) xb_add(&bar[XB_TOPGEN], 1u);
            else XB_SPIN(xb_ld(&bar[XB_TOPGEN]) == tg, bar);
            __builtin_amdgcn_fence(__ATOMIC_ACQUIRE, "agent");
            xb_add(&bar[XB_XGEN(b.x)], 1u);
            asm volatile("s_waitcnt vmcnt(0)" ::: "memory");
        } else {
            XB_SPIN(xb_ld(&bar[XB_XGEN(b.x)]) == gen, bar);
            __builtin_amdgcn_fence(__ATOMIC_ACQUIRE, "agent");
            asm volatile("s_waitcnt vmcnt(0)" ::: "memory");
        }
    }
    __syncthreads();
}


__device__ __forceinline__ void p0_prologue(LAS unsigned char* lds, const int tid, const int lane, const int wave, const int gw, const int NGW,
        const float* x, const float* norm_g, const float* w_in, const float* w_co, const float* w_go, const float* w_o,
        bf16* WinT, bf16* WcoT, bf16* WgoT, bf16* WoT, bf16* H, float* GLR) {
    LAS float* wT = (LAS float*)lds;
    LAS float* scr = (LAS float*)(lds + 65536 + wave * 8448);
    for (int idx = tid; idx < 4096; idx += NT) { const int k = idx >> 2, r4 = idx & 3; const f32x4 w = *(const f32x4*)(w_in + (size_t)k * INW + 5120 + 4 * r4);
        wT[(4 * r4 + 0) * 1024 + k] = w[0]; wT[(4 * r4 + 1) * 1024 + k] = w[1]; wT[(4 * r4 + 2) * 1024 + k] = w[2]; wT[(4 * r4 + 3) * 1024 + k] = w[3]; }
    constexpr int I_IN = 16 * 256, I_SQ = 16 * 32, NITEMS = I_IN + 3 * I_SQ;
    for (int it = gw; it < NITEMS; it += NGW) {
        int r = it;
        if (r < I_IN) { const int nb = r >> 4, kb = r & 15; transpose_item(w_in, INW, srcmap(32 * nb), WinT, D, 32 * nb, 64 * kb, scr, lane); continue; } r -= I_IN;
        const float* W = (r < I_SQ) ? w_co : (r < 2 * I_SQ) ? w_go : w_o; bf16* WT = (r < I_SQ) ? WcoT : (r < 2 * I_SQ) ? WgoT : WoT; r &= (I_SQ - 1);
        const int nb = r >> 4, kb = r & 15; transpose_item(W, D, 32 * nb, WT, D, 32 * nb, 64 * kb, scr, lane);
    }
    __syncthreads();
    f32x4 g[4];
#pragma unroll
    for (int j = 0; j < 4; ++j) g[j] = *(const f32x4*)(norm_g + 256 * j + 4 * lane);
    for (int mp = gw; mp < M / 2; mp += NGW) {
        const int m = 2 * mp;
        const f32x4* xr = (const f32x4*)(x + (size_t)m * D) + lane;
        f32x4 v0[4], v1[4]; float s0 = 0.f, s1 = 0.f;
#pragma unroll
        for (int j = 0; j < 4; ++j) { v0[j] = __builtin_nontemporal_load(xr + 64 * j); v1[j] = __builtin_nontemporal_load(xr + 256 + 64 * j);
            s0 += (v0[j][0] * v0[j][0] + v0[j][1] * v0[j][1]) + (v0[j][2] * v0[j][2] + v0[j][3] * v0[j][3]);
            s1 += (v1[j][0] * v1[j][0] + v1[j][1] * v1[j][1]) + (v1[j][2] * v1[j][2] + v1[j][3] * v1[j][3]); }
        const float r0 = 1.0f / sqrtf(wave_sum(s0) * (1.0f / D) + EPS), r1 = 1.0f / sqrtf(wave_sum(s1) * (1.0f / D) + EPS);
        unsigned long long* o8 = (unsigned long long*)(H + (size_t)m * D) + lane;
#pragma unroll
        for (int j = 0; j < 4; ++j) { v0[j] = v0[j] * r0 * g[j]; v1[j] = v1[j] * r1 * g[j];
            o8[64 * j] = (unsigned long long)pk2(v0[j][0], v0[j][1]) | ((unsigned long long)pk2(v0[j][2], v0[j][3]) << 32);
            o8[256 + 64 * j] = (unsigned long long)pk2(v1[j][0], v1[j][1]) | ((unsigned long long)pk2(v1[j][2], v1[j][3]) << 32); }
        float p0[16], p1[16];
#pragma unroll
        for (int r = 0; r < 16; ++r) { float a0 = 0.f, a1 = 0.f;
#pragma unroll
            for (int j = 0; j < 4; ++j) { const f32x4 w = *(const LAS f32x4*)(wT + r * 1024 + 256 * j + 4 * lane);
                a0 += (v0[j][0] * w[0] + v0[j][1] * w[1]) + (v0[j][2] * w[2] + v0[j][3] * w[3]); a1 += (v1[j][0] * w[0] + v1[j][1] * w[1]) + (v1[j][2] * w[2] + v1[j][3] * w[3]); }
            p0[r] = a0; p1[r] = a1; }
        const float t0 = reduce16(p0, lane), t1 = reduce16(p1, lane);
        if ((lane & 3) == 0) { GLR[(size_t)m * 16 + (lane >> 2)] = t0; GLR[(size_t)m * 16 + 16 + (lane >> 2)] = t1; }
    }
}

__device__ __forceinline__ void conv_tile(LAS unsigned char* lds, const int tid, const int lane, const int wave, const int tile,
        const float* conv_w, const float* conv_b, const float* ln_g, const float* ln_b, const bf16* U, const bf16* SZ, bf16* UC) {
    constexpr int TT = 128, GRP = 4;
    LAS float* red = (LAS float*)lds;
    const int c0 = 2 * tid, t0 = tile * TT;
    f32x2 w[CONVK];
#pragma unroll
    for (int j = 0; j < CONVK; ++j) w[j] = *(const f32x2*)(conv_w + j * D + c0);
    const f32x2 cb = *(const f32x2*)(conv_b + c0), lg = *(const f32x2*)(ln_g + c0), lb = *(const f32x2*)(ln_b + c0);
    f32x2 win[CONVK - 1 + GRP];
    const bool seq_start = (t0 % SEQ) == 0;
#pragma unroll
    for (int j = 0; j < CONVK - 1; ++j) {
        unsigned uv = 0u; if (!seq_start) uv = *(const unsigned*)(U + (size_t)(t0 - (CONVK - 1) + j) * D + c0);
        win[j] = (f32x2){bflo(uv), bfhi(uv)}; }
    unsigned nxt[GRP], sznxt[GRP];
#pragma unroll
    for (int i = 0; i < GRP; ++i) { nxt[i] = __builtin_nontemporal_load((const unsigned*)(U + (size_t)(t0 + i) * D + c0)); sznxt[i] = __builtin_nontemporal_load((const unsigned*)(SZ + (size_t)(t0 + i) * D + c0)); }
    for (int gi = 0; gi < TT / GRP; ++gi) {
        const int tg = t0 + gi * GRP;
        unsigned szv[GRP];
#pragma unroll
        for (int i = 0; i < GRP; ++i) { win[CONVK - 1 + i] = (f32x2){bflo(nxt[i]), bfhi(nxt[i])}; szv[i] = sznxt[i]; }
        if (gi + 1 < TT / GRP) {
#pragma unroll
            for (int i = 0; i < GRP; ++i) { nxt[i] = __builtin_nontemporal_load((const unsigned*)(U + (size_t)(tg + GRP + i) * D + c0)); sznxt[i] = __builtin_nontemporal_load((const unsigned*)(SZ + (size_t)(tg + GRP + i) * D + c0)); }
        }
        f32x2 cv[GRP]; float st[2 * GRP];
#pragma unroll
        for (int i = 0; i < GRP; ++i) { f32x2 a = cb;
#pragma unroll
            for (int j = 0; j < CONVK; ++j) a = w[j] * win[i + j] + a;
            cv[i] = a; st[2 * i] = a[0] + a[1]; st[2 * i + 1] = a[0] * a[0] + a[1] * a[1]; }
#pragma unroll
        for (int j = 0; j < CONVK - 1; ++j) win[j] = win[j + GRP];
        const float tot = reduce8(st, lane);
        LAS float* rb = red + (gi & 1) * 64;
        if ((lane & 7) == 0) rb[wave * 8 + (lane >> 3)] = tot;
        LDS_BARRIER();
        float pv = rb[lane];
        pv += __shfl_xor(pv, 8); pv += __shfl_xor(pv, 16); pv += __shfl_xor(pv, 32);
#pragma unroll
        for (int i = 0; i < GRP; ++i) {
            const float s1 = __int_as_float(__builtin_amdgcn_readlane(__float_as_int(pv), 2 * i)), s2 = __int_as_float(__builtin_amdgcn_readlane(__float_as_int(pv), 2 * i + 1));
            const float mu = s1 * (1.0f / D), var = fmaxf(s2 * (1.0f / D) - mu * mu, 0.f), rstd = __builtin_amdgcn_rsqf(var + EPS);
            float y0 = (cv[i][0] - mu) * rstd * lg[0] + lb[0], y1 = (cv[i][1] - mu) * rstd * lg[1] + lb[1];
            const float z0 = bflo(szv[i]), z1 = bfhi(szv[i]);
            y0 = y0 * sigm(y0) * (z0 * sigm(z0)); y1 = y1 * sigm(y1) * (z1 * sigm(z1));
            __builtin_nontemporal_store(pk2(y0, y1), (unsigned*)(UC + (size_t)(tg + i) * D + c0));
        }
    }
    LDS_BARRIER();
}

constexpr int S128 = 272, S64 = 144;
constexpr int L_QE = 0, L_KE = 17408, L_QB = 34816, L_KLT = 52224, L_VT = 70656, L_P = 79872, L_ST = 89088, L_GLR = 106496, L_SEG = 110592, L_DEC = 112640;
__device__ __forceinline__ void gla_prepass(LAS unsigned char* L, const int tid, const int lane, const int wave, const int pb, const int h, const int n0, const int nu,
        const float* gate_w2, const float* gate_b, const bf16* Q, const bf16* Kb, const float* GLR, bf16* Pg, bf16* QBg, bf16* KLTg, float* DECg) {
    const int d = tid & 127, seg = tid >> 7, lr = lane & 15, lg = lane >> 4;
    const int qrow0 = tid >> 4, qcu = tid & 15, grow = tid >> 2, gcu = tid & 3;
    u32x4 rq[2], rk[2]; f32x4 rg = (f32x4){0.f, 0.f, 0.f, 0.f};
#define PP_LOAD(u) do { const int h_ = h; const size_t t0_ = (size_t)((u) >> 2) * CHUNK; \
        _Pragma("unroll") for (int i = 0; i < 2; ++i) { rq[i] = __builtin_nontemporal_load((const u32x4*)(Q + (t0_ + qrow0 + 32 * i) * KD + h_ * DK + qcu * 8)); rk[i] = __builtin_nontemporal_load((const u32x4*)(Kb + (t0_ + qrow0 + 32 * i) * KD + h_ * DK + qcu * 8)); } \
        if (tid < 256) rg = *(const f32x4*)(GLR + (t0_ + grow) * 16 + gcu * 4); } while (0)
#define PP_STORE() do { \
        _Pragma("unroll") for (int i = 0; i < 2; ++i) { *(LAS u32x4*)(L + L_QE + (qrow0 + 32 * i) * S128 + qcu * 16) = rq[i]; *(LAS u32x4*)(L + L_KE + (qrow0 + 32 * i) * S128 + qcu * 16) = rk[i]; } \
        if (tid < 256) *(LAS f32x4*)(L + L_GLR + grow * 64 + gcu * 16) = rg; } while (0)
    const int u0 = (pb * NCHUNK + n0) * NH + h;
    float w2[16];
#pragma unroll
    for (int r = 0; r < 16; ++r) w2[r] = gate_w2[r * KD + h * DK + d];
    const float gb = gate_b[h * DK + d];
    PP_LOAD(u0);
    PP_STORE();
    LDS_BARRIER();
    for (int ui = 0; ui < nu; ++ui) {
        const int u = u0 + 4 * ui;
        if (ui + 1 < nu) PP_LOAD(u + 4);
        float bb[16]; float run = 0.f;
#pragma unroll
        for (int i = 0; i < 16; ++i) {
            const LAS f32x4* gp = (const LAS f32x4*)(L + L_GLR + (seg * 16 + i) * 64);
            float z = gb;
#pragma unroll
            for (int r4 = 0; r4 < 4; ++r4) { const f32x4 gv = gp[r4]; z += (gv[0] * w2[4 * r4] + gv[1] * w2[4 * r4 + 1]) + (gv[2] * w2[4 * r4 + 2] + gv[3] * w2[4 * r4 + 3]); }
            const float ls = fminf(z, 0.f) - 0.6931471805599453f * __builtin_amdgcn_logf(1.0f + __expf(-fabsf(z)));
            run += ls * (1.0f / 16.0f); bb[i] = run; }
        ((LAS float*)(L + L_SEG))[seg * 128 + d] = run;
        LDS_BARRIER();
        float offs = 0.f, ref, last;
        { const LAS float* sp = (const LAS float*)(L + L_SEG); const float s0 = sp[d], s1 = sp[128 + d], s2 = sp[256 + d], s3 = sp[384 + d];
          ref = s0 + s1; last = (s0 + s1) + (s2 + s3); offs = (seg == 0) ? 0.f : (seg == 1) ? s0 : (seg == 2) ? (s0 + s1) : (s0 + s1) + s2; }
        unsigned klt[8]; const float eref = __expf(ref), elr = __expf(last - ref);
#pragma unroll
        for (int i = 0; i < 16; ++i) {
            const int t = seg * 16 + i; const float bt = bb[i] + offs;
            LAS unsigned short* qp = (LAS unsigned short*)(L + L_QE + t * S128 + d * 2); LAS unsigned short* kp = (LAS unsigned short*)(L + L_KE + t * S128 + d * 2);
            const float q = bf2f(*qp), k = bf2f(*kp);
            const float e1 = __expf(bt - ref), e2 = __expf(ref - bt), e3 = e1 * eref, e4 = e2 * elr;
            *qp = f2bf(q * e1); *kp = f2bf(k * e2);
            *(LAS unsigned short*)(L + L_QB + t * S128 + d * 2) = f2bf(q * e3);
            const unsigned kl = f2bf(k * e4);
            if (i & 1) klt[i >> 1] |= kl << 16; else klt[i >> 1] = kl; }
        { LAS u32x4* kd = (LAS u32x4*)(L + L_KLT + d * S64 + seg * 32); kd[0] = (u32x4){klt[0], klt[1], klt[2], klt[3]}; kd[1] = (u32x4){klt[4], klt[5], klt[6], klt[7]}; }
        if (seg == 0) DECg[(size_t)u * 128 + d] = __expf(last);
        LDS_BARRIER();
        { const int ti = wave >> 1;
#pragma unroll
          for (int tjj = 0; tjj < 2; ++tjj) { const int tj = 2 * (wave & 1) + tjj; f32x4 a = (f32x4){0.f, 0.f, 0.f, 0.f};
            if (tj <= ti) {
#pragma unroll
                for (int ks = 0; ks < 4; ++ks) { const bf16x8 af = *(const LAS bf16x8*)(L + L_QE + (16 * ti + lr) * S128 + (ks * 32 + 8 * lg) * 2), bfm = *(const LAS bf16x8*)(L + L_KE + (16 * tj + lr) * S128 + (ks * 32 + 8 * lg) * 2);
                    a = __builtin_amdgcn_mfma_f32_16x16x32_bf16(af, bfm, a, 0, 0, 0); } }
            const int jg = 16 * tj + lr;
#pragma unroll
            for (int r = 0; r < 4; ++r) { const int ig = 16 * ti + 4 * lg + r; *(LAS unsigned short*)(L + L_P + ig * S64 + jg * 2) = f2bf((jg <= ig) ? a[r] : 0.f); } } }
        LDS_BARRIER();
        { const int prow = tid >> 3, pcu = tid & 7;
          __builtin_nontemporal_store(*(const LAS u32x4*)(L + L_P + prow * S64 + pcu * 16), (u32x4*)(Pg + (size_t)u * 4096 + prow * 64 + pcu * 8));
#pragma unroll
          for (int i = 0; i < 2; ++i) { const int idx = tid + 512 * i;
            __builtin_nontemporal_store(*(const LAS u32x4*)(L + L_QB + (idx >> 4) * S128 + (idx & 15) * 16), (u32x4*)(QBg + (size_t)u * 8192 + (idx >> 4) * 128 + (idx & 15) * 8));
            __builtin_nontemporal_store(*(const LAS u32x4*)(L + L_KLT + (idx >> 3) * S64 + (idx & 7) * 16), (u32x4*)(KLTg + (size_t)u * 8192 + (idx >> 3) * 64 + (idx & 7) * 8)); } }
        if (ui + 1 < nu) PP_STORE();
        LDS_BARRIER();
    }
#undef PP_LOAD
#undef PP_STORE
}

__device__ __forceinline__ void gla_chain(LAS unsigned char* L, const int tid, const int lane, const int wave, const int chain,
        const bf16* V, const bf16* Pg, const bf16* QBg, const bf16* KLTg, const float* DECg, bf16* O, float* SSQP, unsigned* cnt, const float* gn_g, const bf16* SGR, bf16* OG) {
    constexpr int C_P = 0, C_QB = 9216, C_KLT = 26624, C_VT = 45056, C_DEC = 54272, C_BUF = 55296, C_ST = 110592, C_SQ = C_ST + 17408;
    static_assert(C_SQ + 2 * SEQ * 4 <= LDS_MISC, "chain LDS map");
    const int vs = chain & 3, h = (chain >> 2) & 3, b = chain >> 4;
    const int lr = lane & 15, lg = lane >> 4;
    f32x4 stacc[4];
#pragma unroll
    for (int c = 0; c < 4; ++c) stacc[c] = (f32x4){0.f, 0.f, 0.f, 0.f};
    for (int i = tid; i < 17408 / 4; i += NT) ((LAS unsigned*)(L + C_ST))[i] = 0u;
    const int prow = tid >> 3, pcu = tid & 7;
    const int qrow0 = tid >> 4, qcu = tid & 15;
    const size_t tokb = (size_t)b * SEQ;
    LAS float* const sq = (LAS float*)(L + C_SQ);
    u32x4 rp, rqb[2], rkl[2], rv; f32x4 rdec = (f32x4){0.f, 0.f, 0.f, 0.f};
#define CH_LOAD(n) do { const size_t u_ = (size_t)((b * NCHUNK + (n)) * NH + h); \
        rp = *(const u32x4*)(Pg + u_ * 4096 + prow * 64 + pcu * 8); \
        _Pragma("unroll") for (int i = 0; i < 2; ++i) { rqb[i] = *(const u32x4*)(QBg + u_ * 8192 + (qrow0 + 32 * i) * 128 + qcu * 8); rkl[i] = *(const u32x4*)(KLTg + u_ * 8192 + (prow + 64 * i) * 64 + pcu * 8); } \
        rv = __builtin_nontemporal_load((const u32x4*)(V + (tokb + (size_t)(n) * CHUNK + prow) * D + h * DV + vs * 64 + pcu * 8)); \
        rdec = *(const f32x4*)(DECg + u_ * 128 + (tid & 31) * 4); } while (0)
#define CH_STORE(B) do { \
        *(LAS u32x4*)((B) + C_P + prow * S64 + pcu * 16) = rp; \
        _Pragma("unroll") for (int i = 0; i < 2; ++i) { *(LAS u32x4*)((B) + C_QB + (qrow0 + 32 * i) * S128 + qcu * 16) = rqb[i]; *(LAS u32x4*)((B) + C_KLT + (prow + 64 * i) * S64 + pcu * 16) = rkl[i]; } \
        { const unsigned vv[4] = {rv.x, rv.y, rv.z, rv.w}; \
          _Pragma("unroll") for (int e = 0; e < 4; ++e) { *(LAS unsigned short*)((B) + C_VT + (pcu * 8 + 2 * e) * S64 + prow * 2) = (unsigned short)(vv[e] & 0xffffu); \
                                                         *(LAS unsigned short*)((B) + C_VT + (pcu * 8 + 2 * e + 1) * S64 + prow * 2) = (unsigned short)(vv[e] >> 16); } } \
        *(LAS f32x4*)((B) + C_DEC + (tid & 31) * 16) = rdec; } while (0)
    CH_LOAD(0);
    CH_STORE(L);
    CH_LOAD(1);
    __syncthreads();
    for (int n = 0; n < NCHUNK; ++n) {
        LAS unsigned char* const Bc = L + (n & 1) * C_BUF; LAS unsigned char* const Bn = L + ((n & 1) ^ 1) * C_BUF;
        LAS unsigned char* const Sc = L + C_ST;
        const size_t tok0 = tokb + (size_t)n * CHUNK;
        if (n + 1 < NCHUNK) { CH_STORE(Bn); if (n + 2 < NCHUNK) CH_LOAD(n + 2); }
        { const int ti = wave & 3, tv0 = 2 * (wave >> 2); f32x4 a0 = (f32x4){0.f, 0.f, 0.f, 0.f}, a1 = a0;
#pragma unroll
          for (int ks = 0; ks < 2; ++ks) { const bf16x8 af = *(const LAS bf16x8*)(Bc + C_P + (16 * ti + lr) * S64 + (ks * 32 + 8 * lg) * 2);
            const bf16x8 b0 = *(const LAS bf16x8*)(Bc + C_VT + (16 * tv0 + lr) * S64 + (ks * 32 + 8 * lg) * 2), b1 = *(const LAS bf16x8*)(Bc + C_VT + (16 * tv0 + 16 + lr) * S64 + (ks * 32 + 8 * lg) * 2);
            a0 = __builtin_amdgcn_mfma_f32_16x16x32_bf16(b0, af, a0, 0, 0, 0); a1 = __builtin_amdgcn_mfma_f32_16x16x32_bf16(b1, af, a1, 0, 0, 0); }
#pragma unroll
          for (int ks = 0; ks < 4; ++ks) { const bf16x8 af = *(const LAS bf16x8*)(Bc + C_QB + (16 * ti + lr) * S128 + (ks * 32 + 8 * lg) * 2);
            const bf16x8 b0 = *(const LAS bf16x8*)(Sc + (16 * tv0 + lr) * S128 + (ks * 32 + 8 * lg) * 2), b1 = *(const LAS bf16x8*)(Sc + (16 * tv0 + 16 + lr) * S128 + (ks * 32 + 8 * lg) * 2);
            a0 = __builtin_amdgcn_mfma_f32_16x16x32_bf16(b0, af, a0, 0, 0, 0); a1 = __builtin_amdgcn_mfma_f32_16x16x32_bf16(b1, af, a1, 0, 0, 0); }
          { bf16* op = O + (tok0 + 16 * ti + lr) * D + h * DV + vs * 64 + 16 * tv0 + 4 * lg;
            u32x2 w0, w1; w0.x = (unsigned)f2bf(a0[0]) | ((unsigned)f2bf(a0[1]) << 16); w0.y = (unsigned)f2bf(a0[2]) | ((unsigned)f2bf(a0[3]) << 16);
            w1.x = (unsigned)f2bf(a1[0]) | ((unsigned)f2bf(a1[1]) << 16); w1.y = (unsigned)f2bf(a1[2]) | ((unsigned)f2bf(a1[3]) << 16);
            __builtin_nontemporal_store(w0, (u32x2*)op); __builtin_nontemporal_store(w1, (u32x2*)(op + 16)); }
          { float s_ = ((a0[0] * a0[0] + a0[1] * a0[1]) + (a0[2] * a0[2] + a0[3] * a0[3])) + ((a1[0] * a1[0] + a1[1] * a1[1]) + (a1[2] * a1[2] + a1[3] * a1[3]));
            s_ += __shfl_xor(s_, 16); s_ += __shfl_xor(s_, 32);
            if (lg == 0) sq[(wave >> 2) * SEQ + n * CHUNK + 16 * ti + lr] = s_; } }
        { const int tv = wave & 3; bf16x8 vf[2];
#pragma unroll
          for (int ks = 0; ks < 2; ++ks) vf[ks] = *(const LAS bf16x8*)(Bc + C_VT + (16 * tv + lr) * S64 + (ks * 32 + 8 * lg) * 2);
#pragma unroll
          for (int c = 0; c < 4; ++c) { const int td = (wave >> 2) * 4 + c; const f32x4 dec4 = *(const LAS f32x4*)(Bc + C_DEC + (16 * td + 4 * lg) * 4);
            f32x4 a = stacc[c] * dec4;
#pragma unroll
            for (int ks = 0; ks < 2; ++ks) { const bf16x8 kf = *(const LAS bf16x8*)(Bc + C_KLT + (16 * td + lr) * S64 + (ks * 32 + 8 * lg) * 2);
                a = __builtin_amdgcn_mfma_f32_16x16x32_bf16(kf, vf[ks], a, 0, 0, 0); }
            stacc[c] = a; } }
        LDS_BARRIER();
        if (n + 1 < NCHUNK) { const int tv = wave & 3;
#pragma unroll
          for (int c = 0; c < 4; ++c) { const int td = (wave >> 2) * 4 + c; u32x2 w; w.x = (unsigned)f2bf(stacc[c][0]) | ((unsigned)f2bf(stacc[c][1]) << 16); w.y = (unsigned)f2bf(stacc[c][2]) | ((unsigned)f2bf(stacc[c][3]) << 16);
            *(LAS u32x2*)(Sc + (16 * tv + lr) * S128 + (16 * td + 4 * lg) * 2) = w; } }
        LDS_BARRIER();
    }
#undef CH_LOAD
#undef CH_STORE
#pragma unroll
    for (int j = 0; j < SEQ / NT; ++j) { const int t = tid + NT * j;
        const unsigned long long pr = (unsigned long long)__float_as_uint(sq[t]) | ((unsigned long long)__float_as_uint(sq[SEQ + t]) << 32);
        __hip_atomic_store((unsigned long long*)(SSQP + ((size_t)(h * 4 + vs) * M + tokb + t) * 2), pr, __ATOMIC_RELAXED, __HIP_MEMORY_SCOPE_AGENT); }
    asm volatile("s_waitcnt vmcnt(0)" ::: "memory");
    __syncthreads();
    if (tid == 0) {
        unsigned* c = cnt + (b * NH + h) * 64;
        (void)__hip_atomic_fetch_add(c, 1u, __ATOMIC_RELAXED, __HIP_MEMORY_SCOPE_AGENT);
        unsigned spins = 0;
        while (__hip_atomic_load(c, __ATOMIC_RELAXED, __HIP_MEMORY_SCOPE_AGENT) < 4u) { __builtin_amdgcn_s_sleep(2); if (++spins > (1u << 24)) break; }
    }
    __syncthreads();
    { LAS float* rt = (LAS float*)L;
#pragma unroll
      for (int j = 0; j < SEQ / NT; ++j) { const int t = tid + NT * j; float ssq = 0.f;
#pragma unroll
        for (int v4 = 0; v4 < 4; ++v4) { const float* sp = SSQP + ((size_t)(h * 4 + v4) * M + tokb + t) * 2;
            ssq += __hip_atomic_load(sp, __ATOMIC_RELAXED, __HIP_MEMORY_SCOPE_AGENT) + __hip_atomic_load(sp + 1, __ATOMIC_RELAXED, __HIP_MEMORY_SCOPE_AGENT); }
        rt[t] = 1.0f / sqrtf(ssq * (1.0f / DV) + EPS); }
      __syncthreads();
      const int c8 = (tid & 7) * 8, colh = vs * 64 + c8;
      const f32x4 g0 = *(const f32x4*)(gn_g + colh), g1 = *(const f32x4*)(gn_g + colh + 4);
      for (int pass0 = 0; pass0 < SEQ / 64; pass0 += 8) {
        u32x4 ov[8], sgv[8];
#pragma unroll
        for (int j = 0; j < 8; ++j) { const size_t off = (tokb + (pass0 + j) * 64 + (tid >> 3)) * D + h * DV + colh; ov[j] = __builtin_nontemporal_load((const u32x4*)(O + off)); sgv[j] = __builtin_nontemporal_load((const u32x4*)(SGR + off)); }
#pragma unroll
        for (int j = 0; j < 8; ++j) { const int t = (pass0 + j) * 64 + (tid >> 3); const size_t off = (tokb + t) * D + h * DV + colh;
            const float rstd = rt[t];
            const u32x4 o = ov[j], sg = sgv[j]; u32x4 w;
            const float q0 = bflo(sg.x), q1 = bfhi(sg.x), q2 = bflo(sg.y), q3 = bfhi(sg.y), q4 = bflo(sg.z), q5 = bfhi(sg.z), q6 = bflo(sg.w), q7 = bfhi(sg.w);
            w.x = pk2(bflo(o.x) * rstd * g0[0] * (q0 * sigm(q0)), bfhi(o.x) * rstd * g0[1] * (q1 * sigm(q1)));
            w.y = pk2(bflo(o.y) * rstd * g0[2] * (q2 * sigm(q2)), bfhi(o.y) * rstd * g0[3] * (q3 * sigm(q3)));
            w.z = pk2(bflo(o.z) * rstd * g1[0] * (q4 * sigm(q4)), bfhi(o.z) * rstd * g1[1] * (q5 * sigm(q5)));
            w.w = pk2(bflo(o.w) * rstd * g1[2] * (q6 * sigm(q6)), bfhi(o.w) * rstd * g1[3] * (q7 * sigm(q7)));
            __builtin_nontemporal_store(w, (u32x4*)(OG + off)); }
      }
      __syncthreads(); }
}

__device__ __forceinline__ void final_rows(const int lane, const int gw, const int NGW, const float* final_g, const float* ROWSS, float* out) {
    f32x4 g[4];
#pragma unroll
    for (int j = 0; j < 4; ++j) g[j] = *(const f32x4*)(final_g + 256 * j + 4 * lane);
    for (int m = gw; m < M; m += NGW) {
        float ssq = 0.f;
#pragma unroll
        for (int j = 0; j < 4; ++j) { const f32x4 p = *(const f32x4*)(ROWSS + ((size_t)j * M + m) * 4); ssq += (p[0] + p[1]) + (p[2] + p[3]); }
        const float rstd = 1.0f / sqrtf(ssq * (1.0f / D) + EPS);
        f32x4* xr = (f32x4*)(out + (size_t)m * D) + lane;
#pragma unroll
        for (int j = 0; j < 4; ++j) { const f32x4 v = xr[64 * j]; xr[64 * j] = v * rstd * g[j]; }
    }
}

__global__ void __launch_bounds__(NT, 2) fwd_megakernel(Args args) {
    extern __shared__ __attribute__((aligned(16))) unsigned char lds[];
    cg::grid_group grid = cg::this_grid();
#define GRID_SYNC() do { asm volatile("s_waitcnt vmcnt(0)" ::: "memory"); grid.sync(); asm volatile("buffer_inv sc1\n\ts_waitcnt vmcnt(0)" ::: "memory"); } while (0)
    LAS unsigned char* const L = (LAS unsigned char*)lds;
    const int tid = threadIdx.x, lane = tid & 63, wave = __builtin_amdgcn_readfirstlane(tid >> 6);
    const int G = gridDim.x; int bx = blockIdx.x, vcu = (G % 8 == 0) ? (bx % 8) * (G / 8) + bx / 8 : bx;
    int gw = vcu * NWAVES + wave; const int NGW = G * NWAVES;
    unsigned char* const ws = args.ws; unsigned char* const ob = (unsigned char*)args.out;
    if (tid < 4) ((LAS unsigned*)(L + LDS_MISC))[tid] = 0u;
    __syncthreads();
    const XcdBarrier xbar = xcd_barrier_post((unsigned*)(ws + WS_CTL), (volatile LAS unsigned*)(L + LDS_MISC));
#define XCD_SYNC() xcd_barrier(xbar)
#define P_WIN  ((bf16*)(ws + WS_WIN))
#define P_WCO  ((bf16*)(ws + WS_WCO))
#define P_WGO  ((bf16*)(ws + WS_WGO))
#define P_WO   ((bf16*)(ws + WS_WO))
#define P_GLR  ((float*)(ws + WS_GLR))
#define P_SSQP ((float*)(ws + WS_SSQP))
#define P_ROWSS ((float*)(ws + WS_ROWSS))
#ifndef P_H
#define P_H    ((bf16*)ob)
#endif
#define P_UC   ((bf16*)ob)
#define P_U    ((bf16*)(ob + 64 * MiB))
#define P_SZ   ((bf16*)(ws + WS_SZ))
#define P_YCM  ((bf16*)(ws + WS_Q))
#define P_Q    ((bf16*)(ws + WS_Q))
#define P_K    ((bf16*)(ws + WS_K))
#define P_Y    ((bf16*)(ws + WS_V))
#define P_V    ((bf16*)(ws + WS_V))
#define P_OG   ((bf16*)(ob + 64 * MiB))
#define P_SGR  ((bf16*)(ws + WS_SGR))
#define P_MC   ((bf16*)(ws + WS_MC))
#define P_MG   ((bf16*)(ws + WS_MG))
#define P_O    ((bf16*)(ws + WS_SZ))
#define P_PP   ((bf16*)(ws + WS_PP))
#define P_PQB  ((bf16*)(ws + WS_PQB))
#define P_PKLT ((bf16*)(ws + WS_PKLT))
#define P_PDEC ((float*)(ws + WS_PDEC))
#define P_CNT  ((unsigned*)(ws + WS_CNT))
#define P_CNT2 ((unsigned*)(ws + WS_CNT + 32768))

    const int lo = args.ph_lo, hi = args.ph_hi;
#define IN(k) (lo <= (k) && (k) < hi)
#define SEAM(k) do { if (IN(k) && IN((k) + 1)) { if (args.ph_hi > 1000) GRID_SYNC(); else XCD_SYNC(); } } while (0)
#ifndef REP_PHASE
#define REP_PHASE -1
#endif
#define REP(k) (REP_PHASE == (k) ? 2 : 1)
#define RUN_P0() do { \
    p0_prologue(L, tid, lane, wave, gw, NGW, args.in[0], args.in[1], args.in[2], args.in[7], args.in[11], args.in[12], P_WIN, P_WCO, P_WGO, P_WO, P_H, P_GLR); } while (0)
#define RUN_P1() do { pg8::Gemm g{P_H, P_WIN, M, NPROJ, D}; pg8::StaticOrder S; S.init(M, NPROJ, G, bx); EpiProj E{P_U, ws}; \
    pg8::gemm_phase<EpiProj, pg8::StaticOrder, PG8_ALIGN, PG8_SP2>(L, g, S, E); } while (0)
#define RUN_P2() do { \
    for (int t = vcu; t < M / 128; t += G) conv_tile(L, tid, lane, wave, t, args.in[3], args.in[4], args.in[5], args.in[6], P_U, P_SZ, P_UC); \
    {   \
      for (int v = vcu; v < BATCH * NH * 4; v += G) gla_prepass(L, tid, lane, wave, v >> 4, (v >> 2) & 3, (v & 3) * (NCHUNK / 4), NCHUNK / 4, args.in[8], args.in[9], P_Q, P_K, P_GLR, P_PP, P_PQB, P_PKLT, P_PDEC); } } while (0)
#define RUN_P3() do { \
    for (int c = vcu; c < BATCH * NH * 4; c += G) gla_chain(L, tid, lane, wave, c, P_V, P_PP, P_PQB, P_PKLT, P_PDEC, P_O, P_SSQP, P_CNT, args.in[10], P_SGR, P_OG); } while (0)
#define RUN_P4() do { pg8::Gemm g{P_UC, P_WCO, 2 * M, 2 * D, D}; BranchOrder S; S.init(G, bx); EpiBranches E{P_Y, P_YCM, P_MC, P_MG}; \
    pg8::gemm_phase<EpiBranches, BranchOrder, PG8_ALIGN, PG8_SP2>(L, g, S, E); } while (0)
#define RUN_P5() do { pg8::Gemm g{P_Y, P_WO, M, D, D}; EpiResNorm E{args.out, args.in[0], args.in[13], P_ROWSS, P_CNT2}; \
    _Pragma("unroll 1") for (int hf = 0; hf < 2; ++hf) { HalfOrder S; S.init(M / 2, D, G, bx); S.pmoff = hf * (M / 512); \
      pg8::gemm_phase<EpiResNorm, HalfOrder, false, PG8_SP2>(L, g, S, E); } } while (0)
#define RUN_P6() do { } while (0)

    if (IN(0)) RUN_P0();
#if REP_PHASE == 0
    XCD_SYNC(); RUN_P0();
#endif
    SEAM(0);
    if (IN(0) && IN(1)) {
        volatile LAS unsigned* ms = (volatile LAS unsigned*)(L + LDS_MISC);
        if (tid == 0) { unsigned* bar = (unsigned*)(ws + WS_CTL); unsigned pop = 0u, below = 0u; bool ok = (G % 8 == 0);
            for (unsigned j = 0; j < 16; ++j) { const unsigned cj = xb_ld(&bar[XB_XCNT(j)]); if (cj) { ++pop; if (j < xbar.x) ++below; if (cj != (unsigned)(G / 8)) ok = false; } }
            ok = ok && pop == 8u && ms[2] < (unsigned)(G / 8);
            ms[3] = ok ? (below + 8u * ms[2]) : (unsigned)blockIdx.x; }
        __syncthreads();
        bx = __builtin_amdgcn_readfirstlane((int)ms[3]); vcu = (G % 8 == 0) ? (bx % 8) * (G / 8) + bx / 8 : bx; gw = vcu * NWAVES + wave;
    }
    if (IN(1)) RUN_P1();
#if REP_PHASE == 1
    XCD_SYNC(); RUN_P1();
#endif
    SEAM(1);
    if (IN(2)) RUN_P2();
#if REP_PHASE == 2
    XCD_SYNC(); RUN_P2();
#endif
    SEAM(2);
    if (IN(3)) RUN_P3();
#if REP_PHASE == 3
    XCD_SYNC(); RUN_P3();
#endif
    SEAM(3);
    if (IN(4)) RUN_P4();
#if REP_PHASE == 4
    XCD_SYNC(); RUN_P4();
#endif
    SEAM(4);
    if (IN(5)) RUN_P5();
#if REP_PHASE == 5
    XCD_SYNC(); RUN_P5();
#endif
#ifdef DUMP_SRC
    if (IN(7)) { const bf16* src = DUMP_SRC;
#ifndef DUMP_ROWS
#define DUMP_ROWS M
#endif
        for (int m = gw; m < M; m += NGW) { u32x4 a = (u32x4){0u, 0u, 0u, 0u}, b = a; if (m < DUMP_ROWS) { a = *(const u32x4*)(src + (size_t)m * D + 8 * lane); b = *(const u32x4*)(src + (size_t)m * D + 512 + 8 * lane); }
            float* o = args.out + (size_t)m * D + 8 * lane;
            *(f32x4*)(o) = (f32x4){bflo(a.x), bfhi(a.x), bflo(a.y), bfhi(a.y)}; *(f32x4*)(o + 4) = (f32x4){bflo(a.z), bfhi(a.z), bflo(a.w), bfhi(a.w)};
            *(f32x4*)(o + 512) = (f32x4){bflo(b.x), bfhi(b.x), bflo(b.y), bfhi(b.y)}; *(f32x4*)(o + 516) = (f32x4){bflo(b.z), bfhi(b.z), bflo(b.w), bfhi(b.w)}; } }
#endif
}

extern "C" void kernel_launch(void* const* d_in, const int* in_sizes, int n_in, void* d_out, int out_size, void* d_ws, size_t ws_size, hipStream_t stream) {
    static int grid = 0;
    if (grid == 0) {
        if (n_in != 14 || in_sizes[0] != M * D || out_size != M * D || ws_size < WS_END) { fprintf(stderr, "kernel_launch: unexpected shapes (n_in %d, in0 %d, out %d, ws %zu)\n", n_in, n_in > 0 ? in_sizes[0] : -1, out_size, ws_size); grid = -1; return; }
        int dev = 0, cus = 0, per_cu = 0;
        if (hipGetDevice(&dev) != hipSuccess || hipDeviceGetAttribute(&cus, hipDeviceAttributeMultiprocessorCount, dev) != hipSuccess) { grid = -1; return; }
        if (hipFuncSetAttribute((const void*)fwd_megakernel, hipFuncAttributeMaxDynamicSharedMemorySize, LDS_BYTES) != hipSuccess) { fprintf(stderr, "kernel_launch: hipFuncSetAttribute failed\n"); grid = -1; return; }
        if (hipOccupancyMaxActiveBlocksPerMultiprocessor(&per_cu, (const void*)fwd_megakernel, NT, LDS_BYTES) != hipSuccess || per_cu < 1) { fprintf(stderr, "kernel_launch: occupancy query says %d\n", per_cu); per_cu = 1; }
        (void)hipGetLastError();
        grid = cus;
        if (grid != 256) fprintf(stderr, "kernel_launch: note: %d CUs (built for 256: the GLA chains expect one chain per workgroup)\n", grid);
    }
    if (grid < 0) return;
    if (hipMemsetAsync((char*)d_ws + WS_CTL, 0, CTL_ZERO_BYTES, stream) != hipSuccess) { fprintf(stderr, "kernel_launch: hipMemsetAsync failed\n"); return; }
    Args a{};
    for (int i = 0; i < 14; ++i) a.in[i] = (const float*)d_in[i];
    a.out = (float*)d_out; a.ws = (unsigned char*)d_ws;
    void* kargs[] = {&a};
    for (int li = 0; li < MK_N_LAUNCHES + MK_DUMP; ++li) {
#ifdef MK_LAST_PHASE
        if (li >= MK_LAST_PHASE && li < 7) continue;
#endif
        a.ph_lo = (MK_N_LAUNCHES == 1) ? 0 : li; a.ph_hi = (MK_N_LAUNCHES == 1) ? 6 : li + 1;
        const hipError_t e = hipLaunchCooperativeKernel((const void*)fwd_megakernel, dim3(grid), dim3(NT), kargs, LDS_BYTES, stream);
        if (e != hipSuccess) fprintf(stderr, "kernel_launch: cooperative launch failed: %s (grid %d)\n", hipGetErrorString(e), grid);
    }
}
```

```cpp
#include <hip/hip_runtime.h>
#include <hip/hip_cooperative_groups.h>
#include <cstdio>
#include <cstdint>
namespace cg = cooperative_groups;
namespace pg8 {
#define PG8_LAS __attribute__((address_space(3)))
typedef unsigned short bf16_t;
typedef short bf16x8 __attribute__((ext_vector_type(8)));
typedef float f32x4 __attribute__((ext_vector_type(4)));
typedef unsigned u32x4 __attribute__((ext_vector_type(4)));
constexpr int BM = 256, BK = 64, HALF = 128, HTB = HALF * BK * 2  , STAGE_BYTES = 8 * HTB, NXCD = 8, WGM = 4;

__host__ __device__ __forceinline__ int lds_byte(int r, int c) { const int st = (r >> 4) * 2 + (c >> 5), rr = r & 15, cc = c & 31, ob = rr * 64 + cc * 2; return st * 1024 + (ob ^ (((ob >> 9) & 1) << 5)); }
__host__ __device__ __forceinline__ void stage_rc(int b, int& R, int& C) { const int st = b / 1024, sb = b % 1024, swz = sb ^ (((sb >> 9) & 1) << 5); R = (st >> 1) * 16 + swz / 64; C = (st & 1) * 32 + (swz % 64) / 2; }
__host__ __device__ __forceinline__ int perm32(int rho) { const int n = rho >> 4, i = rho & 15; return 8 * (i >> 2) + 4 * n + (i & 3); }

struct Unit { int pm, pn; };
struct Gemm { const bf16_t* A; const bf16_t* Bt; int M, N, K; };

struct StaticOrder {
    int nM, nN, nwg, G, c;
    __host__ __device__ void init(int M, int N, int G_, int c_) { nM = M / BM; nN = N / BM; nwg = nM * nN; G = G_; c = c_; }
    __host__ __device__ bool next(int i, Unit& u) const {
        const long L = (long)i * G + c; if (L >= nwg) return false;
        int wgid = (int)L; { const int q = nwg / NXCD, r = nwg % NXCD, xcd = wgid % NXCD, off = wgid / NXCD; wgid = (xcd < r ? xcd * (q + 1) : r * (q + 1) + (xcd - r) * q) + off; }
        const int nig = WGM * nN, gid = wgid / nig, fm = gid * WGM, gsz = (nM - fm) < WGM ? (nM - fm) : WGM;
        u.pm = fm + ((wgid % nig) % gsz); u.pn = (wgid % nig) / gsz; return true;
    }
    __device__ __forceinline__ void a_ready(const Unit&) const {}
    __device__ __forceinline__ void done(const Unit&) const {}
};
__device__ __forceinline__ unsigned cvt_pk_bf16(float lo, float hi) { unsigned r; asm volatile("v_cvt_pk_bf16_f32 %0, %1, %2" : "=v"(r) : "v"(lo), "v"(hi)); return r; }
typedef float f32x2 __attribute__((ext_vector_type(2)));
template <class Epi, class Sched, bool ALIGN_EPI = false, bool SP2 = false>
__device__ __forceinline__ void gemm_phase(PG8_LAS unsigned char* lds, const Gemm g, const Sched& S, const Epi& E) {
    const int tid = threadIdx.x, wid = __builtin_amdgcn_readfirstlane(tid >> 6), lane = tid & 63, wr = wid >> 2, wc = wid & 3, fr = lane & 15, fq = lane >> 4;
    const int K = g.K, nt = K / BK;
    unsigned voffA[2], voffB[2];
#pragma unroll
    for (int i = 0; i < 2; ++i) { int R, C; stage_rc(tid * 16 + i * 8192, R, C); const int Rb = Epi::PERM ? ((R & ~31) + perm32(R & 31)) : R;
        voffA[i] = (unsigned)(R * K + C) * 2u; voffB[i] = (unsigned)(Rb * K + C) * 2u; }
    const size_t kstep = (size_t)(BK * 2);
    const size_t hstep = (size_t)HALF * K * 2;
    const size_t tstep = 2 * hstep;
    const unsigned ldsw = (unsigned)wid * 1024u;
    const int aoff = lds_byte(wr * 64 + fr, fq * 8), boff = lds_byte(wc * 32 + fr, fq * 8);
#define PG8_SA(b, h) (((b) * 2 + (h)) * HTB)
#define PG8_SB(b, h) ((4 + (b) * 2 + (h)) * HTB)
#define PG8_STAGE(bufoff, gbase, voff) do { _Pragma("unroll") for (int _i = 0; _i < 2; ++_i) \
        __builtin_amdgcn_global_load_lds((const unsigned*)((const char*)(gbase) + (voff)[_i]), (PG8_LAS unsigned*)(lds + (bufoff) + ldsw + _i * 8192), 16, 0, 0); } while (0)
#define PG8_LDA(dst, b, h) do { _Pragma("unroll") for (int m = 0; m < 4; ++m) _Pragma("unroll") for (int k = 0; k < 2; ++k) dst[m][k] = *(const PG8_LAS bf16x8*)(lds + PG8_SA(b, h) + aoff + m * 2048 + k * 1024); } while (0)
#define PG8_LDB(dst, b, h) do { _Pragma("unroll") for (int n = 0; n < 2; ++n) _Pragma("unroll") for (int k = 0; k < 2; ++k) dst[n][k] = *(const PG8_LAS bf16x8*)(lds + PG8_SB(b, h) + boff + n * 2048 + k * 1024); } while (0)
#define PG8_MMA(ai, bj, At, Bt) do { __builtin_amdgcn_s_setprio(1); _Pragma("unroll") for (int m = 0; m < 4; ++m) _Pragma("unroll") for (int n = 0; n < 2; ++n) _Pragma("unroll") for (int k = 0; k < 2; ++k) \
        acc[ai][bj][m][n] = __builtin_amdgcn_mfma_f32_16x16x32_bf16(Bt[n][k], At[m][k], acc[ai][bj][m][n], 0, 0, 0); __builtin_amdgcn_s_setprio(0); } while (0)
#define PG8_WAIT_V(n) asm volatile("s_waitcnt vmcnt(" #n ")" ::: "memory")
#define PG8_WAIT_L(n) asm volatile("s_waitcnt lgkmcnt(" #n ")" ::: "memory")
#define PG8_BAR __builtin_amdgcn_s_barrier()
#define PG8_SCHED __builtin_amdgcn_sched_barrier(0)
    Unit cur, nxt; int ui = 0;
    if (!S.next(0, cur)) return;
    f32x4 acc[2][2][4][2];
#pragma unroll
    for (int a = 0; a < 2; ++a)
#pragma unroll
        for (int b = 0; b < 2; ++b)
#pragma unroll
            for (int m = 0; m < 4; ++m)
#pragma unroll
                for (int n = 0; n < 2; ++n) acc[a][b][m][n] = (f32x4){0.f, 0.f, 0.f, 0.f};
    bf16x8 At[4][2], B0[2][2], B1[2][2];
    const char* cA = (const char*)g.A + (size_t)cur.pm * tstep; const char* cB = (const char*)g.Bt + (size_t)cur.pn * tstep;
    S.a_ready(cur);
    if constexpr (SP2) {
        PG8_STAGE(PG8_SB(0, 0), cB, voffB); PG8_STAGE(PG8_SB(0, 1), cB + hstep, voffB); PG8_STAGE(PG8_SA(0, 0), cA, voffA); PG8_STAGE(PG8_SA(0, 1), cA + hstep, voffA);
        if (wr == 1) PG8_BAR;
        PG8_WAIT_V(2); PG8_BAR;
        PG8_STAGE(PG8_SB(1, 0), cB + kstep, voffB); PG8_STAGE(PG8_SA(1, 0), cA + kstep, voffA); PG8_STAGE(PG8_SB(1, 1), cB + hstep + kstep, voffB);
        PG8_WAIT_V(6); PG8_BAR;
    } else {
        PG8_STAGE(PG8_SB(0, 0), cB, voffB); PG8_STAGE(PG8_SA(0, 0), cA, voffA); PG8_STAGE(PG8_SB(0, 1), cB + hstep, voffB); PG8_STAGE(PG8_SA(0, 1), cA + hstep, voffA);
        if (wr == 1) PG8_BAR;
        PG8_WAIT_V(4); PG8_BAR;
        PG8_STAGE(PG8_SB(1, 0), cB + kstep, voffB); PG8_STAGE(PG8_SA(1, 0), cA + kstep, voffA); PG8_STAGE(PG8_SB(1, 1), cB + hstep + kstep, voffB);
        PG8_WAIT_V(6); PG8_BAR;
    }
    for (;;) {
        const bool has_next = S.next(ui + 1, nxt);
        const char* nA = has_next ? (const char*)g.A + (size_t)nxt.pm * tstep : cA; const char* nB = has_next ? (const char*)g.Bt + (size_t)nxt.pn * tstep : cB;
        for (int t = 0; t < nt; t += 2) {
            const bool last = (t == nt - 2);
            const char* a1 = cA + (size_t)(t + 1) * kstep;
            const char* a2 = last ? nA : cA + (size_t)(t + 2) * kstep; const char* b2 = last ? nB : cB + (size_t)(t + 2) * kstep;
            const char* a3 = a2 + kstep; const char* b3 = b2 + kstep;
            if (last && has_next) S.a_ready(nxt);
            if constexpr (SP2) {
            PG8_LDB(B0, 0, 0); PG8_LDB(B1, 0, 1); PG8_SCHED; PG8_LDA(At, 0, 0); PG8_STAGE(PG8_SA(1, 1), a1 + hstep, voffA);
            PG8_WAIT_V(8); PG8_WAIT_L(0); PG8_BAR; PG8_MMA(0, 0, At, B0); PG8_MMA(0, 1, At, B1); PG8_BAR; PG8_SCHED;
            PG8_LDA(At, 0, 1); PG8_STAGE(PG8_SB(0, 0), b2, voffB); PG8_STAGE(PG8_SB(0, 1), b2 + hstep, voffB); PG8_STAGE(PG8_SA(0, 0), a2, voffA);
            PG8_WAIT_V(8); PG8_WAIT_L(0); PG8_BAR; PG8_MMA(1, 0, At, B0); PG8_MMA(1, 1, At, B1); PG8_BAR; PG8_SCHED;
            PG8_LDB(B0, 1, 0); PG8_LDB(B1, 1, 1); PG8_SCHED; PG8_LDA(At, 1, 0); PG8_STAGE(PG8_SA(0, 1), a2 + hstep, voffA);
            PG8_WAIT_V(8); PG8_WAIT_L(0); PG8_BAR; PG8_MMA(0, 0, At, B0); PG8_MMA(0, 1, At, B1); PG8_BAR; PG8_SCHED;
            PG8_LDA(At, 1, 1); PG8_STAGE(PG8_SB(1, 0), b3, voffB); PG8_STAGE(PG8_SB(1, 1), b3 + hstep, voffB); PG8_STAGE(PG8_SA(1, 0), a3, voffA);
            PG8_WAIT_V(8); PG8_WAIT_L(0); PG8_BAR; PG8_MMA(1, 0, At, B0); PG8_MMA(1, 1, At, B1); PG8_BAR; PG8_SCHED;
            } else {
            PG8_LDB(B0, 0, 0); PG8_SCHED; PG8_LDA(At, 0, 0); PG8_STAGE(PG8_SA(1, 1), a1 + hstep, voffA);
            PG8_WAIT_L(8); PG8_BAR; PG8_WAIT_L(0); PG8_MMA(0, 0, At, B0); PG8_BAR; PG8_SCHED;
            PG8_LDB(B1, 0, 1); PG8_STAGE(PG8_SB(0, 0), b2, voffB);
            PG8_BAR; PG8_WAIT_L(0); PG8_MMA(0, 1, At, B1); PG8_BAR;
            PG8_LDA(At, 0, 1); PG8_STAGE(PG8_SA(0, 0), a2, voffA);
            PG8_BAR; PG8_WAIT_L(0); PG8_MMA(1, 0, At, B0); PG8_BAR; PG8_SCHED;
            PG8_STAGE(PG8_SB(0, 1), b2 + hstep, voffB);
            PG8_WAIT_V(6); PG8_BAR; PG8_MMA(1, 1, At, B1); PG8_BAR;
            PG8_LDB(B0, 1, 0); PG8_SCHED; PG8_LDA(At, 1, 0); PG8_STAGE(PG8_SA(0, 1), a2 + hstep, voffA);
            PG8_WAIT_L(8); PG8_BAR; PG8_WAIT_L(0); PG8_MMA(0, 0, At, B0); PG8_BAR; PG8_SCHED;
            PG8_LDB(B1, 1, 1); PG8_STAGE(PG8_SB(1, 0), b3, voffB);
            PG8_BAR; PG8_WAIT_L(0); PG8_MMA(0, 1, At, B1); PG8_BAR;
            PG8_LDA(At, 1, 1); PG8_STAGE(PG8_SA(1, 0), a3, voffA);
            PG8_BAR; PG8_WAIT_L(0); PG8_MMA(1, 0, At, B0); PG8_BAR; PG8_SCHED;
            PG8_STAGE(PG8_SB(1, 1), b3 + hstep, voffB);
            PG8_WAIT_V(6); PG8_BAR; PG8_MMA(1, 1, At, B1); PG8_BAR;
            }
        }
        if constexpr (ALIGN_EPI) { if (wr == 0) PG8_BAR; }
        if constexpr (!Epi::AFTER_DRAIN) { E(acc, cur, wr, wc, fr, fq); S.done(cur); }
        if (!has_next) break;
#pragma unroll
        for (int a = 0; a < 2; ++a)
#pragma unroll
            for (int b = 0; b < 2; ++b)
#pragma unroll
                for (int m = 0; m < 4; ++m)
#pragma unroll
                    for (int n = 0; n < 2; ++n) acc[a][b][m][n] = (f32x4){0.f, 0.f, 0.f, 0.f};
        cur = nxt; cA = nA; cB = nB; ++ui;
        if constexpr (ALIGN_EPI) { if (wr == 1) PG8_BAR; }
    }
    PG8_WAIT_V(0);
    if constexpr (!ALIGN_EPI) { if (wr == 0) PG8_BAR; }
    PG8_BAR;
    if constexpr (Epi::AFTER_DRAIN) { E.fused(acc, cur, wr, wc, fr, fq, lds, wid, lane); S.done(cur); }
#undef PG8_SA
#undef PG8_SB
#undef PG8_STAGE
#undef PG8_LDA
#undef PG8_LDB
#undef PG8_MMA
#undef PG8_WAIT_V
#undef PG8_WAIT_L
#undef PG8_BAR
#undef PG8_SCHED
}
}

#ifndef MK_N_LAUNCHES
#define MK_N_LAUNCHES 1
#endif
#ifdef DUMP_SRC
#define MK_DUMP 1
#else
#define MK_DUMP 0
#endif
#ifndef PG8_SP2
#define PG8_SP2 true
#endif
#ifndef PG8_ALIGN
#define PG8_ALIGN true
#endif

constexpr int D = 1024, BATCH = 16, SEQ = 2048, M = BATCH * SEQ;
constexpr int INW = 8208, NPROJ = 8192;
constexpr int CONVK = 31, NH = 4, DK = 128, DV = 256, KD = 512, RANK = 16, CHUNK = 64, NCHUNK = SEQ / CHUNK;
constexpr float EPS = 1e-6f;
constexpr int NWAVES = 8, NT = NWAVES * 64;

constexpr size_t MiB = 1u << 20;
constexpr size_t WS_WIN = 1 * MiB, WS_WCO = 17 * MiB, WS_WGO = 19 * MiB, WS_WO = 21 * MiB;
constexpr size_t WS_GLR = 23 * MiB;
constexpr size_t WS_SSQP = 25 * MiB;
constexpr size_t WS_ROWSS = 29 * MiB;
constexpr size_t WS_CTL = 0, CTL_ZERO_BYTES = 131072;
constexpr size_t WS_CNT = 65536;
constexpr size_t WS_SZ = 32 * MiB;
constexpr size_t WS_Q = 96 * MiB;
constexpr size_t WS_K = 128 * MiB;
constexpr size_t WS_V = 160 * MiB;
constexpr size_t WS_SGR = 224 * MiB;
constexpr size_t WS_MC = 288 * MiB;
constexpr size_t WS_MG = 352 * MiB;
constexpr size_t WS_PP = 416 * MiB, WS_PQB = 432 * MiB, WS_PKLT = 464 * MiB, WS_PDEC = 496 * MiB;
constexpr size_t WS_END = 497 * MiB;

constexpr int LDS_BYTES = 147456;
constexpr int LDS_MISC = 147200;

#define LAS __attribute__((address_space(3)))
typedef unsigned short bf16;
typedef float f32x4 __attribute__((ext_vector_type(4)));
typedef float f32x2 __attribute__((ext_vector_type(2)));
typedef short bf16x8 __attribute__((ext_vector_type(8)));
typedef unsigned u32x4 __attribute__((ext_vector_type(4)));
typedef unsigned u32x2 __attribute__((ext_vector_type(2)));

__device__ __forceinline__ float bf2f(unsigned b) { return __uint_as_float(b << 16); }
__device__ __forceinline__ float bflo(unsigned w) { return __uint_as_float(w << 16); }
__device__ __forceinline__ float bfhi(unsigned w) { return __uint_as_float(w & 0xffff0000u); }
typedef __bf16 bf16v2 __attribute__((ext_vector_type(2)));
__device__ __forceinline__ unsigned pk2(float lo, float hi) { return pg8::cvt_pk_bf16(lo, hi); }
__device__ __forceinline__ unsigned short f2bf(float f) { return __builtin_bit_cast(unsigned short, (__bf16)f); }
__device__ __forceinline__ float sigm(float x) { return __builtin_amdgcn_rcpf(1.0f + __expf(-x)); }
#define LDS_BARRIER() do { asm volatile("s_waitcnt lgkmcnt(0)" ::: "memory"); __builtin_amdgcn_s_barrier(); asm volatile("" ::: "memory"); } while (0)
__device__ __forceinline__ float wave_sum(float v) {
#pragma unroll
    for (int o = 1; o < 64; o <<= 1) v += __shfl_xor(v, o);
    return v;
}
__device__ __forceinline__ float reduce16(const float (&v)[16], int lane) {
    float a[8], b[4], c[2], d;
    const bool h5 = lane & 32, h4 = lane & 16, h3 = lane & 8, h2 = lane & 4;
#pragma unroll
    for (int i = 0; i < 8; ++i) { const float mine = h5 ? v[8 + i] : v[i], theirs = h5 ? v[i] : v[8 + i]; a[i] = mine + __shfl_xor(theirs, 32); }
#pragma unroll
    for (int i = 0; i < 4; ++i) { const float mine = h4 ? a[4 + i] : a[i], theirs = h4 ? a[i] : a[4 + i]; b[i] = mine + __shfl_xor(theirs, 16); }
#pragma unroll
    for (int i = 0; i < 2; ++i) { const float mine = h3 ? b[2 + i] : b[i], theirs = h3 ? b[i] : b[2 + i]; c[i] = mine + __shfl_xor(theirs, 8); }
    { const float mine = h2 ? c[1] : c[0], theirs = h2 ? c[0] : c[1]; d = mine + __shfl_xor(theirs, 4); }
    d += __shfl_xor(d, 2); d += __shfl_xor(d, 1);
    return d;
}

__device__ __forceinline__ float reduce8(const float (&v)[8], int lane) {
    float a[4], b[2], c;
    const bool h5 = lane & 32, h4 = lane & 16, h3 = lane & 8;
#pragma unroll
    for (int i = 0; i < 4; ++i) { const float mine = h5 ? v[4 + i] : v[i], theirs = h5 ? v[i] : v[4 + i]; a[i] = mine + __shfl_xor(theirs, 32); }
#pragma unroll
    for (int i = 0; i < 2; ++i) { const float mine = h4 ? a[2 + i] : a[i], theirs = h4 ? a[i] : a[2 + i]; b[i] = mine + __shfl_xor(theirs, 16); }
    { const float mine = h3 ? b[1] : b[0], theirs = h3 ? b[0] : b[1]; c = mine + __shfl_xor(theirs, 8); }
    c += __shfl_xor(c, 4); c += __shfl_xor(c, 2); c += __shfl_xor(c, 1);
    return c;
}

struct EpiProj {
    static constexpr bool PERM = true, AFTER_DRAIN = false;
    bf16* U; unsigned char* ws;
    __device__ __forceinline__ void operator()(const f32x4 (&acc)[2][2][4][2], const pg8::Unit& u, int wr, int wc, int fr, int fq) const {
        const int row0 = u.pm * 256 + wr * 64 + fr, pn = u.pn, cw = wc * 32 + 8 * fq;
        if (pn < 8) {
            bf16* base = U + (size_t)row0 * 1024 + pn * 128 + cw;
#pragma unroll
            for (int ai = 0; ai < 2; ++ai)
#pragma unroll
                for (int m = 0; m < 4; ++m) {
                    f32x4 a0 = acc[ai][0][m][0], a1 = acc[ai][0][m][1]; const f32x4 g0 = acc[ai][1][m][0], g1 = acc[ai][1][m][1];
#pragma unroll
                    for (int e = 0; e < 4; ++e) { a0[e] *= sigm(g0[e]); a1[e] *= sigm(g1[e]); }
                    u32x4 w; w.x = pk2(a0[0], a0[1]); w.y = pk2(a0[2], a0[3]); w.z = pk2(a1[0], a1[1]); w.w = pk2(a1[2], a1[3]);
                    __builtin_nontemporal_store(w, (u32x4*)(base + (size_t)(ai * 128 + m * 16) * 1024)); }
        } else {
            size_t boff; int ld, colt, mode; float sc = 1.f;
            if (pn < 12)      { boff = WS_SZ;  ld = 1024; colt = (pn - 8) * 256;  mode = 0; }
            else if (pn < 14) { boff = WS_Q;   ld = 512;  colt = (pn - 12) * 256; mode = 0; sc = 0.08838834764831845f; }
            else if (pn < 16) { boff = WS_K;   ld = 512;  colt = (pn - 14) * 256; mode = 0; }
            else if (pn < 20) { boff = WS_V;   ld = 1024; colt = (pn - 16) * 256; mode = 0; }
            else if (pn < 24) { boff = WS_SGR; ld = 1024; colt = (pn - 20) * 256; mode = 0; }
            else if (pn < 28) { boff = WS_MC;  ld = 1024; colt = (pn - 24) * 256; mode = 2; }
            else              { boff = WS_MG;  ld = 1024; colt = (pn - 28) * 256; mode = 2; }
            bf16* base = (bf16*)(ws + boff);
            base += (size_t)row0 * ld + colt + cw;
#pragma unroll
            for (int ai = 0; ai < 2; ++ai)
#pragma unroll
                for (int m = 0; m < 4; ++m)
#pragma unroll
                    for (int bj = 0; bj < 2; ++bj) {
                        f32x4 v0 = acc[ai][bj][m][0], v1 = acc[ai][bj][m][1];
                        if (mode == 0) { v0 = v0 * sc; v1 = v1 * sc; }
                        else {
#pragma unroll
                            for (int e = 0; e < 4; ++e) { const float s0 = sigm(v0[e]), s1 = sigm(v1[e]); v0[e] = (mode == 1) ? v0[e] * s0 : s0; v1[e] = (mode == 1) ? v1[e] * s1 : s1; }
                        }
                        u32x4 w; w.x = pk2(v0[0], v0[1]); w.y = pk2(v0[2], v0[3]); w.z = pk2(v1[0], v1[1]); w.w = pk2(v1[2], v1[3]);
                        __builtin_nontemporal_store(w, (u32x4*)(base + (size_t)(ai * 128 + m * 16) * ld + bj * 128)); }
        }
    }
};
struct EpiMul {
    static constexpr bool PERM = true, AFTER_DRAIN = false;
    bf16* O; const bf16* G;
    __device__ __forceinline__ void operator()(const f32x4 (&acc)[2][2][4][2], const pg8::Unit& u, int wr, int wc, int fr, int fq) const {
        const size_t off0 = (size_t)(u.pm * 256 + wr * 64 + fr) * 1024 + u.pn * 256 + wc * 32 + 8 * fq;
#pragma unroll
        for (int ai = 0; ai < 2; ++ai) {
            u32x4 gv[4][2];
#pragma unroll
            for (int m = 0; m < 4; ++m)
#pragma unroll
                for (int bj = 0; bj < 2; ++bj) gv[m][bj] = __builtin_nontemporal_load((const u32x4*)(G + off0 + (size_t)(ai * 128 + m * 16) * 1024 + bj * 128));
#pragma unroll
            for (int m = 0; m < 4; ++m)
#pragma unroll
                for (int bj = 0; bj < 2; ++bj) {
                    const size_t off = off0 + (size_t)(ai * 128 + m * 16) * 1024 + bj * 128;
                    const u32x4 g = gv[m][bj]; const f32x4 v0 = acc[ai][bj][m][0], v1 = acc[ai][bj][m][1];
                    u32x4 w; w.x = pk2(v0[0] * bflo(g.x), v0[1] * bfhi(g.x)); w.y = pk2(v0[2] * bflo(g.y), v0[3] * bfhi(g.y));
                    w.z = pk2(v1[0] * bflo(g.z), v1[1] * bfhi(g.z)); w.w = pk2(v1[2] * bflo(g.w), v1[3] * bfhi(g.w));
                    *(u32x4*)(O + off) = w; }
        }
    }
};
struct EpiMerge {
    static constexpr bool PERM = true, AFTER_DRAIN = false;
    bf16* O; const bf16* C; const bf16* G;
    __device__ __forceinline__ void operator()(const f32x4 (&acc)[2][2][4][2], const pg8::Unit& u, int wr, int wc, int fr, int fq) const {
        const size_t off0 = (size_t)(u.pm * 256 + wr * 64 + fr) * 1024 + u.pn * 256 + wc * 32 + 8 * fq;
#pragma unroll
        for (int ai = 0; ai < 2; ++ai) {
            u32x4 gv[4][2], cv[4][2];
#pragma unroll
            for (int m = 0; m < 4; ++m)
#pragma unroll
                for (int bj = 0; bj < 2; ++bj) { const size_t off = off0 + (size_t)(ai * 128 + m * 16) * 1024 + bj * 128; gv[m][bj] = __builtin_nontemporal_load((const u32x4*)(G + off)); cv[m][bj] = __builtin_nontemporal_load((const u32x4*)(C + off)); }
#pragma unroll
            for (int m = 0; m < 4; ++m)
#pragma unroll
                for (int bj = 0; bj < 2; ++bj) {
                    const size_t off = off0 + (size_t)(ai * 128 + m * 16) * 1024 + bj * 128;
                    const u32x4 g = gv[m][bj], c = cv[m][bj]; const f32x4 v0 = acc[ai][bj][m][0], v1 = acc[ai][bj][m][1];
                    u32x4 w; w.x = pk2(bflo(c.x) + v0[0] * bflo(g.x), bfhi(c.x) + v0[1] * bfhi(g.x)); w.y = pk2(bflo(c.y) + v0[2] * bflo(g.y), bfhi(c.y) + v0[3] * bfhi(g.y));
                    w.z = pk2(bflo(c.z) + v1[0] * bflo(g.z), bfhi(c.z) + v1[1] * bfhi(g.z)); w.w = pk2(bflo(c.w) + v1[2] * bflo(g.w), bfhi(c.w) + v1[3] * bfhi(g.w));
                    __builtin_nontemporal_store(w, (u32x4*)(O + off)); }
        }
    }
};
struct EpiRes {
    static constexpr bool PERM = false, AFTER_DRAIN = false;
    float* out; const float* X; float* SS;
    __device__ __forceinline__ void operator()(const f32x4 (&acc)[2][2][4][2], const pg8::Unit& u, int wr, int wc, int fr, int fq) const {
        const int row0 = u.pm * 256 + wr * 64 + fr, col0 = u.pn * 256 + wc * 32 + 4 * fq;
#pragma unroll
        for (int ai = 0; ai < 2; ++ai)
#pragma unroll
            for (int m = 0; m < 4; ++m) {
                const int row = row0 + ai * 128 + m * 16; const size_t off = (size_t)row * 1024 + col0; float s = 0.f;
#pragma unroll
                for (int bj = 0; bj < 2; ++bj)
#pragma unroll
                    for (int n = 0; n < 2; ++n) { const f32x4 r = *(const f32x4*)(X + off + bj * 128 + n * 16) + acc[ai][bj][m][n]; *(f32x4*)(out + off + bj * 128 + n * 16) = r;
                        s += (r[0] * r[0] + r[1] * r[1]) + (r[2] * r[2] + r[3] * r[3]); }
                s += __shfl_xor(s, 16); s += __shfl_xor(s, 32);
                if (fq == 0) SS[((size_t)u.pn * M + row) * 4 + wc] = s; }
    }
};

struct EpiBranches {
    static constexpr bool PERM = true, AFTER_DRAIN = false;
    bf16* Y; bf16* YCM; const bf16* MC; const bf16* MG;
    __device__ __forceinline__ void operator()(const f32x4 (&acc)[2][2][4][2], const pg8::Unit& u, int wr, int wc, int fr, int fq) const {
        if (u.pn < 4) { EpiMul e{YCM, MC}; e(acc, u, wr, wc, fr, fq); }
        else { pg8::Unit v; v.pm = u.pm - M / 256; v.pn = u.pn - 4; EpiMerge e{Y, YCM, MG}; e(acc, v, wr, wc, fr, fq); }
    }
};
struct BranchOrder {
    pg8::StaticOrder base; int nb;
    __device__ __forceinline__ void init(int G, int c) { base.init(M, D, G, c); nb = (base.nwg - c + G - 1) / G; }
    __device__ __forceinline__ bool next(int i, pg8::Unit& u) const { const int s = (i >= nb) ? 1 : 0, j = i - s * nb; if (j >= nb) return false; const bool ok = base.next(j, u); u.pm += s * (M / 256); u.pn += s * 4; return ok; }
    __device__ __forceinline__ void a_ready(const pg8::Unit&) const {}
    __device__ __forceinline__ void done(const pg8::Unit&) const {}
};

struct EpiResNorm {
    static constexpr bool PERM = false, AFTER_DRAIN = true;
    float* out; const float* X; const float* Gn; float* slots; unsigned* cnt;
    __device__ __forceinline__ void fused(f32x4 (&acc)[2][2][4][2], const pg8::Unit& u, int wr, int wc, int fr, int fq, PG8_LAS unsigned char* lds, int wid, int lane) const {
        PG8_LAS float* Pt = (PG8_LAS float*)lds;
        PG8_LAS float* St = (PG8_LAS float*)(lds + 4096);
        const int tid = wid * 64 + lane, col0 = u.pn * 256 + wc * 32 + 4 * fq;
#pragma unroll
        for (int ai = 0; ai < 2; ++ai)
#pragma unroll
            for (int m = 0; m < 4; ++m) {
                const int rl = ai * 128 + wr * 64 + m * 16 + fr; const size_t off = (size_t)(u.pm * 256 + rl) * 1024 + col0; float s = 0.f;
#pragma unroll
                for (int bj = 0; bj < 2; ++bj)
#pragma unroll
                    for (int n = 0; n < 2; ++n) { const f32x4 r = __builtin_nontemporal_load((const f32x4*)(X + off + bj * 128 + n * 16)) + acc[ai][bj][m][n]; acc[ai][bj][m][n] = r;
                        s += (r[0] * r[0] + r[1] * r[1]) + (r[2] * r[2] + r[3] * r[3]); }
                s += __shfl_xor(s, 16); s += __shfl_xor(s, 32);
                if (fq == 0) Pt[rl * 4 + wc] = s; }
        __syncthreads();
        if (tid < 256) { const f32x4 p = *(const PG8_LAS f32x4*)(Pt + tid * 4); __hip_atomic_store(slots + ((size_t)u.pm * 4 + u.pn) * 256 + tid, (p[0] + p[1]) + (p[2] + p[3]), __ATOMIC_RELAXED, __HIP_MEMORY_SCOPE_AGENT); }
        asm volatile("s_waitcnt vmcnt(0)" ::: "memory");
        __syncthreads();
        if (tid == 0) {
            unsigned* c = cnt + u.pm * 64;
            (void)__hip_atomic_fetch_add(c, 1u, __ATOMIC_RELAXED, __HIP_MEMORY_SCOPE_AGENT);
            unsigned spins = 0;
            while (__hip_atomic_load(c, __ATOMIC_RELAXED, __HIP_MEMORY_SCOPE_AGENT) < 4u) { __builtin_amdgcn_s_sleep(1); if (++spins > (1u << 24)) break; }
        }
        __syncthreads();
        if (tid < 256) { float ssq = 0.f;
#pragma unroll
            for (int q = 0; q < 4; ++q) ssq += __hip_atomic_load(slots + ((size_t)u.pm * 4 + q) * 256 + tid, __ATOMIC_RELAXED, __HIP_MEMORY_SCOPE_AGENT);
            St[tid] = 1.0f / sqrtf(ssq * (1.0f / 1024.0f) + 1e-6f); }
        __syncthreads();
#pragma unroll
        for (int ai = 0; ai < 2; ++ai)
#pragma unroll
            for (int m = 0; m < 4; ++m) {
                const int rl = ai * 128 + wr * 64 + m * 16 + fr; const size_t off = (size_t)(u.pm * 256 + rl) * 1024 + col0; const float rstd = St[rl];
#pragma unroll
                for (int bj = 0; bj < 2; ++bj)
#pragma unroll
                    for (int n = 0; n < 2; ++n) { const f32x4 g4 = *(const f32x4*)(Gn + col0 + bj * 128 + n * 16); __builtin_nontemporal_store(acc[ai][bj][m][n] * rstd * g4, (f32x4*)(out + off + bj * 128 + n * 16)); } }
        __syncthreads();
    }
};
struct HalfOrder : pg8::StaticOrder {
    int pmoff;
    __device__ __forceinline__ bool next(int i, pg8::Unit& u) const { const bool ok = pg8::StaticOrder::next(i, u); u.pm += pmoff; return ok; }
};

struct Args { const float* in[14]; float* out; unsigned char* ws; int ph_lo, ph_hi; };

__device__ __forceinline__ int srcmap(int n) {
    if (n < 2048) { const int pn = n >> 8, i = n & 255; return (i < 128) ? (128 * pn + i) : (1024 + 128 * pn + (i - 128)); }
    return (n < 5120) ? n : n + 16;
}
__device__ __forceinline__ void transpose_item(const float* W, int ldw, int src0, bf16* WT, int K, int dst0, int k0, LAS float* scr, int lane) {
#pragma unroll 8
    for (int i = 0; i < 32; ++i) { const int kk = 2 * i + (lane >> 5); scr[kk * 33 + (lane & 31)] = W[(size_t)(k0 + kk) * ldw + src0 + (lane & 31)]; }
    asm volatile("s_waitcnt lgkmcnt(0)" ::: "memory");
    const int c = lane & 7;
#pragma unroll
    for (int j = 0; j < 4; ++j) { const int n = (lane >> 3) + 8 * j; const LAS float* s = scr + (8 * c) * 33 + n;
        u32x4 o; o.x = pk2(s[0 * 33], s[1 * 33]); o.y = pk2(s[2 * 33], s[3 * 33]); o.z = pk2(s[4 * 33], s[5 * 33]); o.w = pk2(s[6 * 33], s[7 * 33]);
        *(u32x4*)(WT + (size_t)(dst0 + n) * K + k0 + 8 * c) = o; }
    asm volatile("s_waitcnt lgkmcnt(0)" ::: "memory");
}

#define XB_TMO      128
#define XB_XCNT(j)  (256  + 64 * (j))
#define XB_XSUB(j)  (1280 + 64 * (j))
#define XB_XGEN(j)  (2304 + 64 * (j))
#define XB_TOP      3328
#define XB_TOPGEN   3392
#define XCD_BAR_WORDS 3456
#define XB_SPIN_CAP (1u << 18)

__device__ __forceinline__ unsigned xb_ld(unsigned* p)              { return __hip_atomic_load(p, __ATOMIC_RELAXED, __HIP_MEMORY_SCOPE_AGENT); }
__device__ __forceinline__ unsigned xb_add(unsigned* p, unsigned v) { return __hip_atomic_fetch_add(p, v, __ATOMIC_RELAXED, __HIP_MEMORY_SCOPE_AGENT); }
__device__ __forceinline__ unsigned xb_xcc_id() { return (unsigned)__builtin_amdgcn_s_getreg((3 << 11) | 20) & 0xFu; }
#define XB_SPIN(cond, bar) do { unsigned _sp = 0; while (cond) { __builtin_amdgcn_s_sleep(1); \
    if ((++_sp & 255u) == 0u) { if (xb_ld(&(bar)[XB_TMO])) break; if (_sp > XB_SPIN_CAP) { atomicAdd(&(bar)[XB_TMO], 1u); break; } } } } while (0)

struct XcdBarrier {
    unsigned* bar; unsigned x;
    volatile LAS unsigned* st;
};

__device__ __forceinline__ XcdBarrier xcd_barrier_post(unsigned* bar, volatile LAS unsigned* st) {
    XcdBarrier b; b.bar = bar; b.x = xb_xcc_id(); b.st = st;
    if (threadIdx.x == 0) st[2] = xb_add(&bar[XB_XCNT(b.x)], 1u);
    return b;
}
__device__ __forceinline__ void xcd_barrier_complete(unsigned* bar, unsigned x, unsigned& nloc, unsigned& nx) {
    const unsigned G = gridDim.x * gridDim.y * gridDim.z;
    unsigned sum, cnt, mine, sp = 0u;
    for (;;) {
        sum = 0u; cnt = 0u; mine = 0u;
#pragma unroll
        for (unsigned j = 0; j < 16; ++j) { const unsigned c = xb_ld(&bar[XB_XCNT(j)]); sum += c; cnt += (c > 0u) ? 1u : 0u; mine = (j == x) ? c : mine; }
        if (sum == G) break;
        __builtin_amdgcn_s_sleep(1);
        if ((++sp & 255u) == 0u) { if (xb_ld(&bar[XB_TMO])) break; if (sp > XB_SPIN_CAP) { atomicAdd(&bar[XB_TMO], 1u); break; } }
    }
    nloc = mine > 0u ? mine : 1u; nx = cnt > 0u ? cnt : 1u;
}

__device__ __forceinline__ void xcd_barrier(const XcdBarrier& b) {
    asm volatile("s_waitcnt vmcnt(0)" ::: "memory");
    __syncthreads();
    if (threadIdx.x == 0) {
        unsigned* bar = b.bar;
        __builtin_amdgcn_s_waitcnt(0);
        unsigned nloc = b.st[0], nx = b.st[1];
        if (nloc == 0u) { xcd_barrier_complete(bar, b.x, nloc, nx); b.st[0] = nloc; b.st[1] = nx; }
        const unsigned old = xb_add(&bar[XB_XSUB(b.x)], 1u);
        const unsigned gen = old / nloc;
        if (old + 1u == (gen + 1u) * nloc) {
            __builtin_amdgcn_fence(__ATOMIC_RELEASE, "agent");
            asm volatile("s_waitcnt vmcnt(0)" ::: "memory");
            const unsigned og = xb_add(&bar[XB_TOP], 1u);
            const unsigned tg = og / nx;
            if (og + 1u == (tg + 1u) * nx) xb_add(&bar[XB_TOPGEN], 1u);
            else XB_SPIN(xb_ld(&bar[XB_TOPGEN]) == tg, bar);
            __builtin_amdgcn_fence(__ATOMIC_ACQUIRE, "agent");
            xb_add(&bar[XB_XGEN(b.x)], 1u);
            asm volatile("s_waitcnt vmcnt(0)" ::: "memory");
        } else {
            XB_SPIN(xb_ld(&bar[XB_XGEN(b.x)]) == gen, bar);
            __builtin_amdgcn_fence(__ATOMIC_ACQUIRE, "agent");
            asm volatile("s_waitcnt vmcnt(0)" ::: "memory");
        }
    }
    __syncthreads();
}


__device__ __forceinline__ void p0_prologue(LAS unsigned char* lds, const int tid, const int lane, const int wave, const int gw, const int NGW,
        const float* x, const float* norm_g, const float* w_in, const float* w_co, const float* w_go, const float* w_o,
        bf16* WinT, bf16* WcoT, bf16* WgoT, bf16* WoT, bf16* H, float* GLR) {
    LAS float* wT = (LAS float*)lds;
    LAS float* scr = (LAS float*)(lds + 65536 + wave * 8448);
    for (int idx = tid; idx < 4096; idx += NT) { const int k = idx >> 2, r4 = idx & 3; const f32x4 w = *(const f32x4*)(w_in + (size_t)k * INW + 5120 + 4 * r4);
        wT[(4 * r4 + 0) * 1024 + k] = w[0]; wT[(4 * r4 + 1) * 1024 + k] = w[1]; wT[(4 * r4 + 2) * 1024 + k] = w[2]; wT[(4 * r4 + 3) * 1024 + k] = w[3]; }
    constexpr int I_IN = 16 * 256, I_SQ = 16 * 32, NITEMS = I_IN + 3 * I_SQ;
    for (int it = gw; it < NITEMS; it += NGW) {
        int r = it;
        if (r < I_IN) { const int nb = r >> 4, kb = r & 15; transpose_item(w_in, INW, srcmap(32 * nb), WinT, D, 32 * nb, 64 * kb, scr, lane); continue; } r -= I_IN;
        const float* W = (r < I_SQ) ? w_co : (r < 2 * I_SQ) ? w_go : w_o; bf16* WT = (r < I_SQ) ? WcoT : (r < 2 * I_SQ) ? WgoT : WoT; r &= (I_SQ - 1);
        const int nb = r >> 4, kb = r & 15; transpose_item(W, D, 32 * nb, WT, D, 32 * nb, 64 * kb, scr, lane);
    }
    __syncthreads();
    f32x4 g[4];
#pragma unroll
    for (int j = 0; j < 4; ++j) g[j] = *(const f32x4*)(norm_g + 256 * j + 4 * lane);
    for (int mp = gw; mp < M / 2; mp += NGW) {
        const int m = 2 * mp;
        const f32x4* xr = (const f32x4*)(x + (size_t)m * D) + lane;
        f32x4 v0[4], v1[4]; float s0 = 0.f, s1 = 0.f;
#pragma unroll
        for (int j = 0; j < 4; ++j) { v0[j] = __builtin_nontemporal_load(xr + 64 * j); v1[j] = __builtin_nontemporal_load(xr + 256 + 64 * j);
            s0 += (v0[j][0] * v0[j][0] + v0[j][1] * v0[j][1]) + (v0[j][2] * v0[j][2] + v0[j][3] * v0[j][3]);
            s1 += (v1[j][0] * v1[j][0] + v1[j][1] * v1[j][1]) + (v1[j][2] * v1[j][2] + v1[j][3] * v1[j][3]); }
        const float r0 = 1.0f / sqrtf(wave_sum(s0) * (1.0f / D) + EPS), r1 = 1.0f / sqrtf(wave_sum(s1) * (1.0f / D) + EPS);
        unsigned long long* o8 = (unsigned long long*)(H + (size_t)m * D) + lane;
#pragma unroll
        for (int j = 0; j < 4; ++j) { v0[j] = v0[j] * r0 * g[j]; v1[j] = v1[j] * r1 * g[j];
            o8[64 * j] = (unsigned long long)pk2(v0[j][0], v0[j][1]) | ((unsigned long long)pk2(v0[j][2], v0[j][3]) << 32);
            o8[256 + 64 * j] = (unsigned long long)pk2(v1[j][0], v1[j][1]) | ((unsigned long long)pk2(v1[j][2], v1[j][3]) << 32); }
        float p0[16], p1[16];
#pragma unroll
        for (int r = 0; r < 16; ++r) { float a0 = 0.f, a1 = 0.f;
#pragma unroll
            for (int j = 0; j < 4; ++j) { const f32x4 w = *(const LAS f32x4*)(wT + r * 1024 + 256 * j + 4 * lane);
                a0 += (v0[j][0] * w[0] + v0[j][1] * w[1]) + (v0[j][2] * w[2] + v0[j][3] * w[3]); a1 += (v1[j][0] * w[0] + v1[j][1] * w[1]) + (v1[j][2] * w[2] + v1[j][3] * w[3]); }
            p0[r] = a0; p1[r] = a1; }
        const float t0 = reduce16(p0, lane), t1 = reduce16(p1, lane);
        if ((lane & 3) == 0) { GLR[(size_t)m * 16 + (lane >> 2)] = t0; GLR[(size_t)m * 16 + 16 + (lane >> 2)] = t1; }
    }
}

__device__ __forceinline__ void conv_tile(LAS unsigned char* lds, const int tid, const int lane, const int wave, const int tile,
        const float* conv_w, const float* conv_b, const float* ln_g, const float* ln_b, const bf16* U, const bf16* SZ, bf16* UC) {
    constexpr int TT = 128, GRP = 4;
    LAS float* red = (LAS float*)lds;
    const int c0 = 2 * tid, t0 = tile * TT;
    f32x2 w[CONVK];
#pragma unroll
    for (int j = 0; j < CONVK; ++j) w[j] = *(const f32x2*)(conv_w + j * D + c0);
    const f32x2 cb = *(const f32x2*)(conv_b + c0), lg = *(const f32x2*)(ln_g + c0), lb = *(const f32x2*)(ln_b + c0);
    f32x2 win[CONVK - 1 + GRP];
    const bool seq_start = (t0 % SEQ) == 0;
#pragma unroll
    for (int j = 0; j < CONVK - 1; ++j) {
        unsigned uv = 0u; if (!seq_start) uv = *(const unsigned*)(U + (size_t)(t0 - (CONVK - 1) + j) * D + c0);
        win[j] = (f32x2){bflo(uv), bfhi(uv)}; }
    unsigned nxt[GRP], sznxt[GRP];
#pragma unroll
    for (int i = 0; i < GRP; ++i) { nxt[i] = __builtin_nontemporal_load((const unsigned*)(U + (size_t)(t0 + i) * D + c0)); sznxt[i] = __builtin_nontemporal_load((const unsigned*)(SZ + (size_t)(t0 + i) * D + c0)); }
    for (int gi = 0; gi < TT / GRP; ++gi) {
        const int tg = t0 + gi * GRP;
        unsigned szv[GRP];
#pragma unroll
        for (int i = 0; i < GRP; ++i) { win[CONVK - 1 + i] = (f32x2){bflo(nxt[i]), bfhi(nxt[i])}; szv[i] = sznxt[i]; }
        if (gi + 1 < TT / GRP) {
#pragma unroll
            for (int i = 0; i < GRP; ++i) { nxt[i] = __builtin_nontemporal_load((const unsigned*)(U + (size_t)(tg + GRP + i) * D + c0)); sznxt[i] = __builtin_nontemporal_load((const unsigned*)(SZ + (size_t)(tg + GRP + i) * D + c0)); }
        }
        f32x2 cv[GRP]; float st[2 * GRP];
#pragma unroll
        for (int i = 0; i < GRP; ++i) { f32x2 a = cb;
#pragma unroll
            for (int j = 0; j < CONVK; ++j) a = w[j] * win[i + j] + a;
            cv[i] = a; st[2 * i] = a[0] + a[1]; st[2 * i + 1] = a[0] * a[0] + a[1] * a[1]; }
#pragma unroll
        for (int j = 0; j < CONVK - 1; ++j) win[j] = win[j + GRP];
        const float tot = reduce8(st, lane);
        LAS float* rb = red + (gi & 1) * 64;
        if ((lane & 7) == 0) rb[wave * 8 + (lane >> 3)] = tot;
        LDS_BARRIER();
        float pv = rb[lane];
        pv += __shfl_xor(pv, 8); pv += __shfl_xor(pv, 16); pv += __shfl_xor(pv, 32);
#pragma unroll
        for (int i = 0; i < GRP; ++i) {
            const float s1 = __int_as_float(__builtin_amdgcn_readlane(__float_as_int(pv), 2 * i)), s2 = __int_as_float(__builtin_amdgcn_readlane(__float_as_int(pv), 2 * i + 1));
            const float mu = s1 * (1.0f / D), var = fmaxf(s2 * (1.0f / D) - mu * mu, 0.f), rstd = __builtin_amdgcn_rsqf(var + EPS);
            float y0 = (cv[i][0] - mu) * rstd * lg[0] + lb[0], y1 = (cv[i][1] - mu) * rstd * lg[1] + lb[1];
            const float z0 = bflo(szv[i]), z1 = bfhi(szv[i]);
            y0 = y0 * sigm(y0) * (z0 * sigm(z0)); y1 = y1 * sigm(y1) * (z1 * sigm(z1));
            __builtin_nontemporal_store(pk2(y0, y1), (unsigned*)(UC + (size_t)(tg + i) * D + c0));
        }
    }
    LDS_BARRIER();
}

constexpr int S128 = 272, S64 = 144;
constexpr int L_QE = 0, L_KE = 17408, L_QB = 34816, L_KLT = 52224, L_VT = 70656, L_P = 79872, L_ST = 89088, L_GLR = 106496, L_SEG = 110592, L_DEC = 112640;
__device__ __forceinline__ void gla_prepass(LAS unsigned char* L, const int tid, const int lane, const int wave, const int pb, const int h, const int n0, const int nu,
        const float* gate_w2, const float* gate_b, const bf16* Q, const bf16* Kb, const float* GLR, bf16* Pg, bf16* QBg, bf16* KLTg, float* DECg) {
    const int d = tid & 127, seg = tid >> 7, lr = lane & 15, lg = lane >> 4;
    const int qrow0 = tid >> 4, qcu = tid & 15, grow = tid >> 2, gcu = tid & 3;
    u32x4 rq[2], rk[2]; f32x4 rg = (f32x4){0.f, 0.f, 0.f, 0.f};
#define PP_LOAD(u) do { const int h_ = h; const size_t t0_ = (size_t)((u) >> 2) * CHUNK; \
        _Pragma("unroll") for (int i = 0; i < 2; ++i) { rq[i] = __builtin_nontemporal_load((const u32x4*)(Q + (t0_ + qrow0 + 32 * i) * KD + h_ * DK + qcu * 8)); rk[i] = __builtin_nontemporal_load((const u32x4*)(Kb + (t0_ + qrow0 + 32 * i) * KD + h_ * DK + qcu * 8)); } \
        if (tid < 256) rg = *(const f32x4*)(GLR + (t0_ + grow) * 16 + gcu * 4); } while (0)
#define PP_STORE() do { \
        _Pragma("unroll") for (int i = 0; i < 2; ++i) { *(LAS u32x4*)(L + L_QE + (qrow0 + 32 * i) * S128 + qcu * 16) = rq[i]; *(LAS u32x4*)(L + L_KE + (qrow0 + 32 * i) * S128 + qcu * 16) = rk[i]; } \
        if (tid < 256) *(LAS f32x4*)(L + L_GLR + grow * 64 + gcu * 16) = rg; } while (0)
    const int u0 = (pb * NCHUNK + n0) * NH + h;
    float w2[16];
#pragma unroll
    for (int r = 0; r < 16; ++r) w2[r] = gate_w2[r * KD + h * DK + d];
    const float gb = gate_b[h * DK + d];
    PP_LOAD(u0);
    PP_STORE();
    LDS_BARRIER();
    for (int ui = 0; ui < nu; ++ui) {
        const int u = u0 + 4 * ui;
        if (ui + 1 < nu) PP_LOAD(u + 4);
        float bb[16]; float run = 0.f;
#pragma unroll
        for (int i = 0; i < 16; ++i) {
            const LAS f32x4* gp = (const LAS f32x4*)(L + L_GLR + (seg * 16 + i) * 64);
            float z = gb;
#pragma unroll
            for (int r4 = 0; r4 < 4; ++r4) { const f32x4 gv = gp[r4]; z += (gv[0] * w2[4 * r4] + gv[1] * w2[4 * r4 + 1]) + (gv[2] * w2[4 * r4 + 2] + gv[3] * w2[4 * r4 + 3]); }
            const float ls = fminf(z, 0.f) - 0.6931471805599453f * __builtin_amdgcn_logf(1.0f + __expf(-fabsf(z)));
            run += ls * (1.0f / 16.0f); bb[i] = run; }
        ((LAS float*)(L + L_SEG))[seg * 128 + d] = run;
        LDS_BARRIER();
        float offs = 0.f, ref, last;
        { const LAS float* sp = (const LAS float*)(L + L_SEG); const float s0 = sp[d], s1 = sp[128 + d], s2 = sp[256 + d], s3 = sp[384 + d];
          ref = s0 + s1; last = (s0 + s1) + (s2 + s3); offs = (seg == 0) ? 0.f : (seg == 1) ? s0 : (seg == 2) ? (s0 + s1) : (s0 + s1) + s2; }
        unsigned klt[8]; const float eref = __expf(ref), elr = __expf(last - ref);
#pragma unroll
        for (int i = 0; i < 16; ++i) {
            const int t = seg * 16 + i; const float bt = bb[i] + offs;
            LAS unsigned short* qp = (LAS unsigned short*)(L + L_QE + t * S128 + d * 2); LAS unsigned short* kp = (LAS unsigned short*)(L + L_KE + t * S128 + d * 2);
            const float q = bf2f(*qp), k = bf2f(*kp);
            const float e1 = __expf(bt - ref), e2 = __expf(ref - bt), e3 = e1 * eref, e4 = e2 * elr;
            *qp = f2bf(q * e1); *kp = f2bf(k * e2);
            *(LAS unsigned short*)(L + L_QB + t * S128 + d * 2) = f2bf(q * e3);
            const unsigned kl = f2bf(k * e4);
            if (i & 1) klt[i >> 1] |= kl << 16; else klt[i >> 1] = kl; }
        { LAS u32x4* kd = (LAS u32x4*)(L + L_KLT + d * S64 + seg * 32); kd[0] = (u32x4){klt[0], klt[1], klt[2], klt[3]}; kd[1] = (u32x4){klt[4], klt[5], klt[6], klt[7]}; }
        if (seg == 0) DECg[(size_t)u * 128 + d] = __expf(last);
        LDS_BARRIER();
        { const int ti = wave >> 1;
#pragma unroll
          for (int tjj = 0; tjj < 2; ++tjj) { const int tj = 2 * (wave & 1) + tjj; f32x4 a = (f32x4){0.f, 0.f, 0.f, 0.f};
            if (tj <= ti) {
#pragma unroll
                for (int ks = 0; ks < 4; ++ks) { const bf16x8 af = *(const LAS bf16x8*)(L + L_QE + (16 * ti + lr) * S128 + (ks * 32 + 8 * lg) * 2), bfm = *(const LAS bf16x8*)(L + L_KE + (16 * tj + lr) * S128 + (ks * 32 + 8 * lg) * 2);
                    a = __builtin_amdgcn_mfma_f32_16x16x32_bf16(af, bfm, a, 0, 0, 0); } }
            const int jg = 16 * tj + lr;
#pragma unroll
            for (int r = 0; r < 4; ++r) { const int ig = 16 * ti + 4 * lg + r; *(LAS unsigned short*)(L + L_P + ig * S64 + jg * 2) = f2bf((jg <= ig) ? a[r] : 0.f); } } }
        LDS_BARRIER();
        { const int prow = tid >> 3, pcu = tid & 7;
          *(u32x4*)(Pg + (size_t)u * 4096 + prow * 64 + pcu * 8) = *(const LAS u32x4*)(L + L_P + prow * S64 + pcu * 16);
#pragma unroll
          for (int i = 0; i < 2; ++i) { const int idx = tid + 512 * i;
            *(u32x4*)(QBg + (size_t)u * 8192 + (idx >> 4) * 128 + (idx & 15) * 8) = *(const LAS u32x4*)(L + L_QB + (idx >> 4) * S128 + (idx & 15) * 16);
            *(u32x4*)(KLTg + (size_t)u * 8192 + (idx >> 3) * 64 + (idx & 7) * 8) = *(const LAS u32x4*)(L + L_KLT + (idx >> 3) * S64 + (idx & 7) * 16); } }
        if (ui + 1 < nu) PP_STORE();
        LDS_BARRIER();
    }
#undef PP_LOAD
#undef PP_STORE
}

__device__ __forceinline__ void gla_chain(LAS unsigned char* L, const int tid, const int lane, const int wave, const int chain,
        const bf16* V, const bf16* Pg, const bf16* QBg, const bf16* KLTg, const float* DECg, bf16* O, float* SSQP, unsigned* cnt, const float* gn_g, const bf16* SGR, bf16* OG) {
    constexpr int C_P = 0, C_QB = 9216, C_KLT = 26624, C_VT = 45056, C_DEC = 54272, C_BUF = 55296, C_ST = 110592, C_SQ = C_ST + 17408;
    static_assert(C_SQ + 2 * SEQ * 4 <= LDS_MISC, "chain LDS map");
    const int vs = chain & 3, h = (chain >> 2) & 3, b = chain >> 4;
    const int lr = lane & 15, lg = lane >> 4;
    f32x4 stacc[4];
#pragma unroll
    for (int c = 0; c < 4; ++c) stacc[c] = (f32x4){0.f, 0.f, 0.f, 0.f};
    for (int i = tid; i < 17408 / 4; i += NT) ((LAS unsigned*)(L + C_ST))[i] = 0u;
    const int prow = tid >> 3, pcu = tid & 7;
    const int qrow0 = tid >> 4, qcu = tid & 15;
    const size_t tokb = (size_t)b * SEQ;
    LAS float* const sq = (LAS float*)(L + C_SQ);
    u32x4 rp, rqb[2], rkl[2], rv; f32x4 rdec = (f32x4){0.f, 0.f, 0.f, 0.f};
#define CH_LOAD(n) do { const size_t u_ = (size_t)((b * NCHUNK + (n)) * NH + h); \
        rp = *(const u32x4*)(Pg + u_ * 4096 + prow * 64 + pcu * 8); \
        _Pragma("unroll") for (int i = 0; i < 2; ++i) { rqb[i] = *(const u32x4*)(QBg + u_ * 8192 + (qrow0 + 32 * i) * 128 + qcu * 8); rkl[i] = *(const u32x4*)(KLTg + u_ * 8192 + (prow + 64 * i) * 64 + pcu * 8); } \
        rv = __builtin_nontemporal_load((const u32x4*)(V + (tokb + (size_t)(n) * CHUNK + prow) * D + h * DV + vs * 64 + pcu * 8)); \
        rdec = *(const f32x4*)(DECg + u_ * 128 + (tid & 31) * 4); } while (0)
#define CH_STORE(B) do { \
        *(LAS u32x4*)((B) + C_P + prow * S64 + pcu * 16) = rp; \
        _Pragma("unroll") for (int i = 0; i < 2; ++i) { *(LAS u32x4*)((B) + C_QB + (qrow0 + 32 * i) * S128 + qcu * 16) = rqb[i]; *(LAS u32x4*)((B) + C_KLT + (prow + 64 * i) * S64 + pcu * 16) = rkl[i]; } \
        { const unsigned vv[4] = {rv.x, rv.y, rv.z, rv.w}; \
          _Pragma("unroll") for (int e = 0; e < 4; ++e) { *(LAS unsigned short*)((B) + C_VT + (pcu * 8 + 2 * e) * S64 + prow * 2) = (unsigned short)(vv[e] & 0xffffu); \
                                                         *(LAS unsigned short*)((B) + C_VT + (pcu * 8 + 2 * e + 1) * S64 + prow * 2) = (unsigned short)(vv[e] >> 16); } } \
        *(LAS f32x4*)((B) + C_DEC + (tid & 31) * 16) = rdec; } while (0)
    CH_LOAD(0);
    CH_STORE(L);
    CH_LOAD(1);
    __syncthreads();
    for (int n = 0; n < NCHUNK; ++n) {
        LAS unsigned char* const Bc = L + (n & 1) * C_BUF; LAS unsigned char* const Bn = L + ((n & 1) ^ 1) * C_BUF;
        LAS unsigned char* const Sc = L + C_ST;
        const size_t tok0 = tokb + (size_t)n * CHUNK;
        if (n + 1 < NCHUNK) { CH_STORE(Bn); if (n + 2 < NCHUNK) CH_LOAD(n + 2); }
        { const int ti = wave & 3, tv0 = 2 * (wave >> 2); f32x4 a0 = (f32x4){0.f, 0.f, 0.f, 0.f}, a1 = a0;
#pragma unroll
          for (int ks = 0; ks < 2; ++ks) { const bf16x8 af = *(const LAS bf16x8*)(Bc + C_P + (16 * ti + lr) * S64 + (ks * 32 + 8 * lg) * 2);
            const bf16x8 b0 = *(const LAS bf16x8*)(Bc + C_VT + (16 * tv0 + lr) * S64 + (ks * 32 + 8 * lg) * 2), b1 = *(const LAS bf16x8*)(Bc + C_VT + (16 * tv0 + 16 + lr) * S64 + (ks * 32 + 8 * lg) * 2);
            a0 = __builtin_amdgcn_mfma_f32_16x16x32_bf16(b0, af, a0, 0, 0, 0); a1 = __builtin_amdgcn_mfma_f32_16x16x32_bf16(b1, af, a1, 0, 0, 0); }
#pragma unroll
          for (int ks = 0; ks < 4; ++ks) { const bf16x8 af = *(const LAS bf16x8*)(Bc + C_QB + (16 * ti + lr) * S128 + (ks * 32 + 8 * lg) * 2);
            const bf16x8 b0 = *(const LAS bf16x8*)(Sc + (16 * tv0 + lr) * S128 + (ks * 32 + 8 * lg) * 2), b1 = *(const LAS bf16x8*)(Sc + (16 * tv0 + 16 + lr) * S128 + (ks * 32 + 8 * lg) * 2);
            a0 = __builtin_amdgcn_mfma_f32_16x16x32_bf16(b0, af, a0, 0, 0, 0); a1 = __builtin_amdgcn_mfma_f32_16x16x32_bf16(b1, af, a1, 0, 0, 0); }
          { bf16* op = O + (tok0 + 16 * ti + lr) * D + h * DV + vs * 64 + 16 * tv0 + 4 * lg;
            u32x2 w0, w1; w0.x = (unsigned)f2bf(a0[0]) | ((unsigned)f2bf(a0[1]) << 16); w0.y = (unsigned)f2bf(a0[2]) | ((unsigned)f2bf(a0[3]) << 16);
            w1.x = (unsigned)f2bf(a1[0]) | ((unsigned)f2bf(a1[1]) << 16); w1.y = (unsigned)f2bf(a1[2]) | ((unsigned)f2bf(a1[3]) << 16);
            *(u32x2*)op = w0; *(u32x2*)(op + 16) = w1; }
          { float s_ = ((a0[0] * a0[0] + a0[1] * a0[1]) + (a0[2] * a0[2] + a0[3] * a0[3])) + ((a1[0] * a1[0] + a1[1] * a1[1]) + (a1[2] * a1[2] + a1[3] * a1[3]));
            s_ += __shfl_xor(s_, 16); s_ += __shfl_xor(s_, 32);
            if (lg == 0) sq[(wave >> 2) * SEQ + n * CHUNK + 16 * ti + lr] = s_; } }
        { const int tv = wave & 3; bf16x8 vf[2];
#pragma unroll
          for (int ks = 0; ks < 2; ++ks) vf[ks] = *(const LAS bf16x8*)(Bc + C_VT + (16 * tv + lr) * S64 + (ks * 32 + 8 * lg) * 2);
#pragma unroll
          for (int c = 0; c < 4; ++c) { const int td = (wave >> 2) * 4 + c; const f32x4 dec4 = *(const LAS f32x4*)(Bc + C_DEC + (16 * td + 4 * lg) * 4);
            f32x4 a = stacc[c] * dec4;
#pragma unroll
            for (int ks = 0; ks < 2; ++ks) { const bf16x8 kf = *(const LAS bf16x8*)(Bc + C_KLT + (16 * td + lr) * S64 + (ks * 32 + 8 * lg) * 2);
                a = __builtin_amdgcn_mfma_f32_16x16x32_bf16(kf, vf[ks], a, 0, 0, 0); }
            stacc[c] = a; } }
        LDS_BARRIER();
        if (n + 1 < NCHUNK) { const int tv = wave & 3;
#pragma unroll
          for (int c = 0; c < 4; ++c) { const int td = (wave >> 2) * 4 + c; u32x2 w; w.x = (unsigned)f2bf(stacc[c][0]) | ((unsigned)f2bf(stacc[c][1]) << 16); w.y = (unsigned)f2bf(stacc[c][2]) | ((unsigned)f2bf(stacc[c][3]) << 16);
            *(LAS u32x2*)(Sc + (16 * tv + lr) * S128 + (16 * td + 4 * lg) * 2) = w; } }
        LDS_BARRIER();
    }
#undef CH_LOAD
#undef CH_STORE
#pragma unroll
    for (int j = 0; j < SEQ / NT; ++j) { const int t = tid + NT * j;
        const unsigned long long pr = (unsigned long long)__float_as_uint(sq[t]) | ((unsigned long long)__float_as_uint(sq[SEQ + t]) << 32);
        __hip_atomic_store((unsigned long long*)(SSQP + ((size_t)(h * 4 + vs) * M + tokb + t) * 2), pr, __ATOMIC_RELAXED, __HIP_MEMORY_SCOPE_AGENT); }
    asm volatile("s_waitcnt vmcnt(0)" ::: "memory");
    __syncthreads();
    if (tid == 0) {
        unsigned* c = cnt + (b * NH + h) * 64;
        (void)__hip_atomic_fetch_add(c, 1u, __ATOMIC_RELAXED, __HIP_MEMORY_SCOPE_AGENT);
        unsigned spins = 0;
        while (__hip_atomic_load(c, __ATOMIC_RELAXED, __HIP_MEMORY_SCOPE_AGENT) < 4u) { __builtin_amdgcn_s_sleep(2); if (++spins > (1u << 24)) break; }
    }
    __syncthreads();
    { LAS float* rt = (LAS float*)L;
#pragma unroll
      for (int j = 0; j < SEQ / NT; ++j) { const int t = tid + NT * j; float ssq = 0.f;
#pragma unroll
        for (int v4 = 0; v4 < 4; ++v4) { const float* sp = SSQP + ((size_t)(h * 4 + v4) * M + tokb + t) * 2;
            ssq += __hip_atomic_load(sp, __ATOMIC_RELAXED, __HIP_MEMORY_SCOPE_AGENT) + __hip_atomic_load(sp + 1, __ATOMIC_RELAXED, __HIP_MEMORY_SCOPE_AGENT); }
        rt[t] = 1.0f / sqrtf(ssq * (1.0f / DV) + EPS); }
      __syncthreads();
      const int c8 = (tid & 7) * 8, colh = vs * 64 + c8;
      const f32x4 g0 = *(const f32x4*)(gn_g + colh), g1 = *(const f32x4*)(gn_g + colh + 4);
      for (int pass0 = 0; pass0 < SEQ / 64; pass0 += 8) {
        u32x4 ov[8], sgv[8];
#pragma unroll
        for (int j = 0; j < 8; ++j) { const size_t off = (tokb + (pass0 + j) * 64 + (tid >> 3)) * D + h * DV + colh; ov[j] = __builtin_nontemporal_load((const u32x4*)(O + off)); sgv[j] = __builtin_nontemporal_load((const u32x4*)(SGR + off)); }
#pragma unroll
        for (int j = 0; j < 8; ++j) { const int t = (pass0 + j) * 64 + (tid >> 3); const size_t off = (tokb + t) * D + h * DV + colh;
            const float rstd = rt[t];
            const u32x4 o = ov[j], sg = sgv[j]; u32x4 w;
            const float q0 = bflo(sg.x), q1 = bfhi(sg.x), q2 = bflo(sg.y), q3 = bfhi(sg.y), q4 = bflo(sg.z), q5 = bfhi(sg.z), q6 = bflo(sg.w), q7 = bfhi(sg.w);
            w.x = pk2(bflo(o.x) * rstd * g0[0] * (q0 * sigm(q0)), bfhi(o.x) * rstd * g0[1] * (q1 * sigm(q1)));
            w.y = pk2(bflo(o.y) * rstd * g0[2] * (q2 * sigm(q2)), bfhi(o.y) * rstd * g0[3] * (q3 * sigm(q3)));
            w.z = pk2(bflo(o.z) * rstd * g1[0] * (q4 * sigm(q4)), bfhi(o.z) * rstd * g1[1] * (q5 * sigm(q5)));
            w.w = pk2(bflo(o.w) * rstd * g1[2] * (q6 * sigm(q6)), bfhi(o.w) * rstd * g1[3] * (q7 * sigm(q7)));
            __builtin_nontemporal_store(w, (u32x4*)(OG + off)); }
      }
      __syncthreads(); }
}

__device__ __forceinline__ void final_rows(const int lane, const int gw, const int NGW, const float* final_g, const float* ROWSS, float* out) {
    f32x4 g[4];
#pragma unroll
    for (int j = 0; j < 4; ++j) g[j] = *(const f32x4*)(final_g + 256 * j + 4 * lane);
    for (int m = gw; m < M; m += NGW) {
        float ssq = 0.f;
#pragma unroll
        for (int j = 0; j < 4; ++j) { const f32x4 p = *(const f32x4*)(ROWSS + ((size_t)j * M + m) * 4); ssq += (p[0] + p[1]) + (p[2] + p[3]); }
        const float rstd = 1.0f / sqrtf(ssq * (1.0f / D) + EPS);
        f32x4* xr = (f32x4*)(out + (size_t)m * D) + lane;
#pragma unroll
        for (int j = 0; j < 4; ++j) { const f32x4 v = xr[64 * j]; xr[64 * j] = v * rstd * g[j]; }
    }
}

__global__ void __launch_bounds__(NT, 2) fwd_megakernel(Args args) {
    extern __shared__ __attribute__((aligned(16))) unsigned char lds[];
    cg::grid_group grid = cg::this_grid();
#define GRID_SYNC() do { asm volatile("s_waitcnt vmcnt(0)" ::: "memory"); grid.sync(); asm volatile("buffer_inv sc1\n\ts_waitcnt vmcnt(0)" ::: "memory"); } while (0)
    LAS unsigned char* const L = (LAS unsigned char*)lds;
    const int tid = threadIdx.x, lane = tid & 63, wave = __builtin_amdgcn_readfirstlane(tid >> 6);
    const int G = gridDim.x; int bx = blockIdx.x, vcu = (G % 8 == 0) ? (bx % 8) * (G / 8) + bx / 8 : bx;
    int gw = vcu * NWAVES + wave; const int NGW = G * NWAVES;
    unsigned char* const ws = args.ws; unsigned char* const ob = (unsigned char*)args.out;
    if (tid < 4) ((LAS unsigned*)(L + LDS_MISC))[tid] = 0u;
    __syncthreads();
    const XcdBarrier xbar = xcd_barrier_post((unsigned*)(ws + WS_CTL), (volatile LAS unsigned*)(L + LDS_MISC));
#define XCD_SYNC() xcd_barrier(xbar)
#define P_WIN  ((bf16*)(ws + WS_WIN))
#define P_WCO  ((bf16*)(ws + WS_WCO))
#define P_WGO  ((bf16*)(ws + WS_WGO))
#define P_WO   ((bf16*)(ws + WS_WO))
#define P_GLR  ((float*)(ws + WS_GLR))
#define P_SSQP ((float*)(ws + WS_SSQP))
#define P_ROWSS ((float*)(ws + WS_ROWSS))
#ifndef P_H
#define P_H    ((bf16*)ob)
#endif
#define P_UC   ((bf16*)ob)
#define P_U    ((bf16*)(ob + 64 * MiB))
#define P_SZ   ((bf16*)(ws + WS_SZ))
#define P_YCM  ((bf16*)(ws + WS_Q))
#define P_Q    ((bf16*)(ws + WS_Q))
#define P_K    ((bf16*)(ws + WS_K))
#define P_Y    ((bf16*)(ws + WS_V))
#define P_V    ((bf16*)(ws + WS_V))
#define P_OG   ((bf16*)(ob + 64 * MiB))
#define P_SGR  ((bf16*)(ws + WS_SGR))
#define P_MC   ((bf16*)(ws + WS_MC))
#define P_MG   ((bf16*)(ws + WS_MG))
#define P_O    ((bf16*)(ws + WS_SZ))
#define P_PP   ((bf16*)(ws + WS_PP))
#define P_PQB  ((bf16*)(ws + WS_PQB))
#define P_PKLT ((bf16*)(ws + WS_PKLT))
#define P_PDEC ((float*)(ws + WS_PDEC))
#define P_CNT  ((unsigned*)(ws + WS_CNT))
#define P_CNT2 ((unsigned*)(ws + WS_CNT + 32768))

    const int lo = args.ph_lo, hi = args.ph_hi;
#define IN(k) (lo <= (k) && (k) < hi)
#define SEAM(k) do { if (IN(k) && IN((k) + 1)) { if (args.ph_hi > 1000) GRID_SYNC(); else XCD_SYNC(); } } while (0)
#ifndef REP_PHASE
#define REP_PHASE -1
#endif
#define REP(k) (REP_PHASE == (k) ? 2 : 1)
#define RUN_P0() do { \
    p0_prologue(L, tid, lane, wave, gw, NGW, args.in[0], args.in[1], args.in[2], args.in[7], args.in[11], args.in[12], P_WIN, P_WCO, P_WGO, P_WO, P_H, P_GLR); } while (0)
#define RUN_P1() do { pg8::Gemm g{P_H, P_WIN, M, NPROJ, D}; pg8::StaticOrder S; S.init(M, NPROJ, G, bx); EpiProj E{P_U, ws}; \
    pg8::gemm_phase<EpiProj, pg8::StaticOrder, PG8_ALIGN, PG8_SP2>(L, g, S, E); } while (0)
#define RUN_P2() do { \
    for (int t = vcu; t < M / 128; t += G) conv_tile(L, tid, lane, wave, t, args.in[3], args.in[4], args.in[5], args.in[6], P_U, P_SZ, P_UC); \
    {   \
      for (int v = vcu; v < BATCH * NH * 4; v += G) gla_prepass(L, tid, lane, wave, v >> 4, (v >> 2) & 3, (v & 3) * (NCHUNK / 4), NCHUNK / 4, args.in[8], args.in[9], P_Q, P_K, P_GLR, P_PP, P_PQB, P_PKLT, P_PDEC); } } while (0)
#define RUN_P3() do { \
    for (int c = vcu; c < BATCH * NH * 4; c += G) gla_chain(L, tid, lane, wave, c, P_V, P_PP, P_PQB, P_PKLT, P_PDEC, P_O, P_SSQP, P_CNT, args.in[10], P_SGR, P_OG); } while (0)
#define RUN_P4() do { pg8::Gemm g{P_UC, P_WCO, 2 * M, 2 * D, D}; BranchOrder S; S.init(G, bx); EpiBranches E{P_Y, P_YCM, P_MC, P_MG}; \
    pg8::gemm_phase<EpiBranches, BranchOrder, PG8_ALIGN, PG8_SP2>(L, g, S, E); } while (0)
#define RUN_P5() do { pg8::Gemm g{P_Y, P_WO, M, D, D}; EpiResNorm E{args.out, args.in[0], args.in[13], P_ROWSS, P_CNT2}; \
    _Pragma("unroll 1") for (int hf = 0; hf < 2; ++hf) { HalfOrder S; S.init(M / 2, D, G, bx); S.pmoff = hf * (M / 512); \
      pg8::gemm_phase<EpiResNorm, HalfOrder, false, PG8_SP2>(L, g, S, E); } } while (0)
#define RUN_P6() do { } while (0)

    if (IN(0)) RUN_P0();
#if REP_PHASE == 0
    XCD_SYNC(); RUN_P0();
#endif
    SEAM(0);
    if (IN(0) && IN(1)) {
        volatile LAS unsigned* ms = (volatile LAS unsigned*)(L + LDS_MISC);
        if (tid == 0) { unsigned* bar = (unsigned*)(ws + WS_CTL); unsigned pop = 0u, below = 0u; bool ok = (G % 8 == 0);
            for (unsigned j = 0; j < 16; ++j) { const unsigned cj = xb_ld(&bar[XB_XCNT(j)]); if (cj) { ++pop; if (j < xbar.x) ++below; if (cj != (unsigned)(G / 8)) ok = false; } }
            ok = ok && pop == 8u && ms[2] < (unsigned)(G / 8);
            ms[3] = ok ? (below + 8u * ms[2]) : (unsigned)blockIdx.x; }
        __syncthreads();
        bx = __builtin_amdgcn_readfirstlane((int)ms[3]); vcu = (G % 8 == 0) ? (bx % 8) * (G / 8) + bx / 8 : bx; gw = vcu * NWAVES + wave;
    }
    if (IN(1)) RUN_P1();
#if REP_PHASE == 1
    XCD_SYNC(); RUN_P1();
#endif
    SEAM(1);
    if (IN(2)) RUN_P2();
#if REP_PHASE == 2
    XCD_SYNC(); RUN_P2();
#endif
    SEAM(2);
    if (IN(3)) RUN_P3();
#if REP_PHASE == 3
    XCD_SYNC(); RUN_P3();
#endif
    SEAM(3);
    if (IN(4)) RUN_P4();
#if REP_PHASE == 4
    XCD_SYNC(); RUN_P4();
#endif
    SEAM(4);
    if (IN(5)) RUN_P5();
#if REP_PHASE == 5
    XCD_SYNC(); RUN_P5();
#endif
#ifdef DUMP_SRC
    if (IN(7)) { const bf16* src = DUMP_SRC;
#ifndef DUMP_ROWS
#define DUMP_ROWS M
#endif
        for (int m = gw; m < M; m += NGW) { u32x4 a = (u32x4){0u, 0u, 0u, 0u}, b = a; if (m < DUMP_ROWS) { a = *(const u32x4*)(src + (size_t)m * D + 8 * lane); b = *(const u32x4*)(src + (size_t)m * D + 512 + 8 * lane); }
            float* o = args.out + (size_t)m * D + 8 * lane;
            *(f32x4*)(o) = (f32x4){bflo(a.x), bfhi(a.x), bflo(a.y), bfhi(a.y)}; *(f32x4*)(o + 4) = (f32x4){bflo(a.z), bfhi(a.z), bflo(a.w), bfhi(a.w)};
            *(f32x4*)(o + 512) = (f32x4){bflo(b.x), bfhi(b.x), bflo(b.y), bfhi(b.y)}; *(f32x4*)(o + 516) = (f32x4){bflo(b.z), bfhi(b.z), bflo(b.w), bfhi(b.w)}; } }
#endif
}

extern "C" void kernel_launch(void* const* d_in, const int* in_sizes, int n_in, void* d_out, int out_size, void* d_ws, size_t ws_size, hipStream_t stream) {
    static int grid = 0;
    if (grid == 0) {
        if (n_in != 14 || in_sizes[0] != M * D || out_size != M * D || ws_size < WS_END) { fprintf(stderr, "kernel_launch: unexpected shapes (n_in %d, in0 %d, out %d, ws %zu)\n", n_in, n_in > 0 ? in_sizes[0] : -1, out_size, ws_size); grid = -1; return; }
        int dev = 0, cus = 0, per_cu = 0;
        if (hipGetDevice(&dev) != hipSuccess || hipDeviceGetAttribute(&cus, hipDeviceAttributeMultiprocessorCount, dev) != hipSuccess) { grid = -1; return; }
        if (hipFuncSetAttribute((const void*)fwd_megakernel, hipFuncAttributeMaxDynamicSharedMemorySize, LDS_BYTES) != hipSuccess) { fprintf(stderr, "kernel_launch: hipFuncSetAttribute failed\n"); grid = -1; return; }
        if (hipOccupancyMaxActiveBlocksPerMultiprocessor(&per_cu, (const void*)fwd_megakernel, NT, LDS_BYTES) != hipSuccess || per_cu < 1) { fprintf(stderr, "kernel_launch: occupancy query says %d\n", per_cu); per_cu = 1; }
        (void)hipGetLastError();
        grid = cus;
        if (grid != 256) fprintf(stderr, "kernel_launch: note: %d CUs (built for 256: the GLA chains expect one chain per workgroup)\n", grid);
    }
    if (grid < 0) return;
    if (hipMemsetAsync((char*)d_ws + WS_CTL, 0, CTL_ZERO_BYTES, stream) != hipSuccess) { fprintf(stderr, "kernel_launch: hipMemsetAsync failed\n"); return; }
    Args a{};
    for (int i = 0; i < 14; ++i) a.in[i] = (const float*)d_in[i];
    a.out = (float*)d_out; a.ws = (unsigned char*)d_ws;
    void* kargs[] = {&a};
    for (int li = 0; li < MK_N_LAUNCHES + MK_DUMP; ++li) {
#ifdef MK_LAST_PHASE
        if (li >= MK_LAST_PHASE && li < 7) continue;
#endif
        a.ph_lo = (MK_N_LAUNCHES == 1) ? 0 : li; a.ph_hi = (MK_N_LAUNCHES == 1) ? 6 : li + 1;
        const hipError_t e = hipLaunchCooperativeKernel((const void*)fwd_megakernel, dim3(grid), dim3(NT), kargs, LDS_BYTES, stream);
        if (e != hipSuccess) fprintf(stderr, "kernel_launch: cooperative launch failed: %s (grid %d)\n", hipGetErrorString(e), grid);
    }
}
```

```cpp
#include <hip/hip_runtime.h>
#include <hip/hip_cooperative_groups.h>
#include <cstdio>
#include <cstdint>
namespace cg = cooperative_groups;
namespace pg8 {
#define PG8_LAS __attribute__((address_space(3)))
typedef unsigned short bf16_t;
typedef short bf16x8 __attribute__((ext_vector_type(8)));
typedef float f32x4 __attribute__((ext_vector_type(4)));
typedef unsigned u32x4 __attribute__((ext_vector_type(4)));
constexpr int BM = 256, BK = 64, HALF = 128, HTB = HALF * BK * 2  , STAGE_BYTES = 8 * HTB, NXCD = 8, WGM = 4;

__host__ __device__ __forceinline__ int lds_byte(int r, int c) { const int st = (r >> 4) * 2 + (c >> 5), rr = r & 15, cc = c & 31, ob = rr * 64 + cc * 2; return st * 1024 + (ob ^ (((ob >> 9) & 1) << 5)); }
__host__ __device__ __forceinline__ void stage_rc(int b, int& R, int& C) { const int st = b / 1024, sb = b % 1024, swz = sb ^ (((sb >> 9) & 1) << 5); R = (st >> 1) * 16 + swz / 64; C = (st & 1) * 32 + (swz % 64) / 2; }
__host__ __device__ __forceinline__ int perm32(int rho) { const int n = rho >> 4, i = rho & 15; return 8 * (i >> 2) + 4 * n + (i & 3); }

struct Unit { int pm, pn; };
struct Gemm { const bf16_t* A; const bf16_t* Bt; int M, N, K; };

struct StaticOrder {
    int nM, nN, nwg, G, c;
    __host__ __device__ void init(int M, int N, int G_, int c_) { nM = M / BM; nN = N / BM; nwg = nM * nN; G = G_; c = c_; }
    __host__ __device__ bool next(int i, Unit& u) const {
        const long L = (long)i * G + c; if (L >= nwg) return false;
        int wgid = (int)L; { const int q = nwg / NXCD, r = nwg % NXCD, xcd = wgid % NXCD, off = wgid / NXCD; wgid = (xcd < r ? xcd * (q + 1) : r * (q + 1) + (xcd - r) * q) + off; }
        const int nig = WGM * nN, gid = wgid / nig, fm = gid * WGM, gsz = (nM - fm) < WGM ? (nM - fm) : WGM;
        u.pm = fm + ((wgid % nig) % gsz); u.pn = (wgid % nig) / gsz; return true;
    }
    __device__ __forceinline__ void a_ready(const Unit&) const {}
    __device__ __forceinline__ void done(const Unit&) const {}
};
__device__ __forceinline__ unsigned cvt_pk_bf16(float lo, float hi) { unsigned r; asm volatile("v_cvt_pk_bf16_f32 %0, %1, %2" : "=v"(r) : "v"(lo), "v"(hi)); return r; }
typedef float f32x2 __attribute__((ext_vector_type(2)));
template <class Epi, class Sched, bool ALIGN_EPI = false, bool SP2 = false>
__device__ __forceinline__ void gemm_phase(PG8_LAS unsigned char* lds, const Gemm g, const Sched& S, const Epi& E) {
    const int tid = threadIdx.x, wid = __builtin_amdgcn_readfirstlane(tid >> 6), lane = tid & 63, wr = wid >> 2, wc = wid & 3, fr = lane & 15, fq = lane >> 4;
    const int K = g.K, nt = K / BK;
    unsigned voffA[2], voffB[2];
#pragma unroll
    for (int i = 0; i < 2; ++i) { int R, C; stage_rc(tid * 16 + i * 8192, R, C); const int Rb = Epi::PERM ? ((R & ~31) + perm32(R & 31)) : R;
        voffA[i] = (unsigned)(R * K + C) * 2u; voffB[i] = (unsigned)(Rb * K + C) * 2u; }
    const size_t kstep = (size_t)(BK * 2);
    const size_t hstep = (size_t)HALF * K * 2;
    const size_t tstep = 2 * hstep;
    const unsigned ldsw = (unsigned)wid * 1024u;
    const int aoff = lds_byte(wr * 64 + fr, fq * 8), boff = lds_byte(wc * 32 + fr, fq * 8);
#define PG8_SA(b, h) (((b) * 2 + (h)) * HTB)
#define PG8_SB(b, h) ((4 + (b) * 2 + (h)) * HTB)
#define PG8_STAGE(bufoff, gbase, voff) do { _Pragma("unroll") for (int _i = 0; _i < 2; ++_i) \
        __builtin_amdgcn_global_load_lds((const unsigned*)((const char*)(gbase) + (voff)[_i]), (PG8_LAS unsigned*)(lds + (bufoff) + ldsw + _i * 8192), 16, 0, 0); } while (0)
#define PG8_LDA(dst, b, h) do { _Pragma("unroll") for (int m = 0; m < 4; ++m) _Pragma("unroll") for (int k = 0; k < 2; ++k) dst[m][k] = *(const PG8_LAS bf16x8*)(lds + PG8_SA(b, h) + aoff + m * 2048 + k * 1024); } while (0)
#define PG8_LDB(dst, b, h) do { _Pragma("unroll") for (int n = 0; n < 2; ++n) _Pragma("unroll") for (int k = 0; k < 2; ++k) dst[n][k] = *(const PG8_LAS bf16x8*)(lds + PG8_SB(b, h) + boff + n * 2048 + k * 1024); } while (0)
#define PG8_MMA(ai, bj, At, Bt) do { __builtin_amdgcn_s_setprio(1); _Pragma("unroll") for (int m = 0; m < 4; ++m) _Pragma("unroll") for (int n = 0; n < 2; ++n) _Pragma("unroll") for (int k = 0; k < 2; ++k) \
        acc[ai][bj][m][n] = __builtin_amdgcn_mfma_f32_16x16x32_bf16(Bt[n][k], At[m][k], acc[ai][bj][m][n], 0, 0, 0); __builtin_amdgcn_s_setprio(0); } while (0)
#define PG8_WAIT_V(n) asm volatile("s_waitcnt vmcnt(" #n ")" ::: "memory")
#define PG8_WAIT_L(n) asm volatile("s_waitcnt lgkmcnt(" #n ")" ::: "memory")
#define PG8_BAR __builtin_amdgcn_s_barrier()
#define PG8_SCHED __builtin_amdgcn_sched_barrier(0)
    Unit cur, nxt; int ui = 0;
    if (!S.next(0, cur)) return;
    f32x4 acc[2][2][4][2];
#pragma unroll
    for (int a = 0; a < 2; ++a)
#pragma unroll
        for (int b = 0; b < 2; ++b)
#pragma unroll
            for (int m = 0; m < 4; ++m)
#pragma unroll
                for (int n = 0; n < 2; ++n) acc[a][b][m][n] = (f32x4){0.f, 0.f, 0.f, 0.f};
    bf16x8 At[4][2], B0[2][2], B1[2][2];
    const char* cA = (const char*)g.A + (size_t)cur.pm * tstep; const char* cB = (const char*)g.Bt + (size_t)cur.pn * tstep;
    S.a_ready(cur);
    if constexpr (SP2) {
        PG8_STAGE(PG8_SB(0, 0), cB, voffB); PG8_STAGE(PG8_SB(0, 1), cB + hstep, voffB); PG8_STAGE(PG8_SA(0, 0), cA, voffA); PG8_STAGE(PG8_SA(0, 1), cA + hstep, voffA);
        if (wr == 1) PG8_BAR;
        PG8_WAIT_V(2); PG8_BAR;
        PG8_STAGE(PG8_SB(1, 0), cB + kstep, voffB); PG8_STAGE(PG8_SA(1, 0), cA + kstep, voffA); PG8_STAGE(PG8_SB(1, 1), cB + hstep + kstep, voffB);
        PG8_WAIT_V(6); PG8_BAR;
    } else {
        PG8_STAGE(PG8_SB(0, 0), cB, voffB); PG8_STAGE(PG8_SA(0, 0), cA, voffA); PG8_STAGE(PG8_SB(0, 1), cB + hstep, voffB); PG8_STAGE(PG8_SA(0, 1), cA + hstep, voffA);
        if (wr == 1) PG8_BAR;
        PG8_WAIT_V(4); PG8_BAR;
        PG8_STAGE(PG8_SB(1, 0), cB + kstep, voffB); PG8_STAGE(PG8_SA(1, 0), cA + kstep, voffA); PG8_STAGE(PG8_SB(1, 1), cB + hstep + kstep, voffB);
        PG8_WAIT_V(6); PG8_BAR;
    }
    for (;;) {
        const bool has_next = S.next(ui + 1, nxt);
        const char* nA = has_next ? (const char*)g.A + (size_t)nxt.pm * tstep : cA; const char* nB = has_next ? (const char*)g.Bt + (size_t)nxt.pn * tstep : cB;
        for (int t = 0; t < nt; t += 2) {
            const bool last = (t == nt - 2);
            const char* a1 = cA + (size_t)(t + 1) * kstep;
            const char* a2 = last ? nA : cA + (size_t)(t + 2) * kstep; const char* b2 = last ? nB : cB + (size_t)(t + 2) * kstep;
            const char* a3 = a2 + kstep; const char* b3 = b2 + kstep;
            if (last && has_next) S.a_ready(nxt);
            if constexpr (SP2) {
            PG8_LDB(B0, 0, 0); PG8_LDB(B1, 0, 1); PG8_SCHED; PG8_LDA(At, 0, 0); PG8_STAGE(PG8_SA(1, 1), a1 + hstep, voffA);
            PG8_WAIT_V(8); PG8_WAIT_L(0); PG8_BAR; PG8_MMA(0, 0, At, B0); PG8_MMA(0, 1, At, B1); PG8_BAR; PG8_SCHED;
            PG8_LDA(At, 0, 1); PG8_STAGE(PG8_SB(0, 0), b2, voffB); PG8_STAGE(PG8_SB(0, 1), b2 + hstep, voffB); PG8_STAGE(PG8_SA(0, 0), a2, voffA);
            PG8_WAIT_V(8); PG8_WAIT_L(0); PG8_BAR; PG8_MMA(1, 0, At, B0); PG8_MMA(1, 1, At, B1); PG8_BAR; PG8_SCHED;
            PG8_LDB(B0, 1, 0); PG8_LDB(B1, 1, 1); PG8_SCHED; PG8_LDA(At, 1, 0); PG8_STAGE(PG8_SA(0, 1), a2 + hstep, voffA);
            PG8_WAIT_V(8); PG8_WAIT_L(0); PG8_BAR; PG8_MMA(0, 0, At, B0); PG8_MMA(0, 1, At, B1); PG8_BAR; PG8_SCHED;
            PG8_LDA(At, 1, 1); PG8_STAGE(PG8_SB(1, 0), b3, voffB); PG8_STAGE(PG8_SB(1, 1), b3 + hstep, voffB); PG8_STAGE(PG8_SA(1, 0), a3, voffA);
            PG8_WAIT_V(8); PG8_WAIT_L(0); PG8_BAR; PG8_MMA(1, 0, At, B0); PG8_MMA(1, 1, At, B1); PG8_BAR; PG8_SCHED;
            } else {
            PG8_LDB(B0, 0, 0); PG8_SCHED; PG8_LDA(At, 0, 0); PG8_STAGE(PG8_SA(1, 1), a1 + hstep, voffA);
            PG8_WAIT_L(8); PG8_BAR; PG8_WAIT_L(0); PG8_MMA(0, 0, At, B0); PG8_BAR; PG8_SCHED;
            PG8_LDB(B1, 0, 1); PG8_STAGE(PG8_SB(0, 0), b2, voffB);
            PG8_BAR; PG8_WAIT_L(0); PG8_MMA(0, 1, At, B1); PG8_BAR;
            PG8_LDA(At, 0, 1); PG8_STAGE(PG8_SA(0, 0), a2, voffA);
            PG8_BAR; PG8_WAIT_L(0); PG8_MMA(1, 0, At, B0); PG8_BAR; PG8_SCHED;
            PG8_STAGE(PG8_SB(0, 1), b2 + hstep, voffB);
            PG8_WAIT_V(6); PG8_BAR; PG8_MMA(1, 1, At, B1); PG8_BAR;
            PG8_LDB(B0, 1, 0); PG8_SCHED; PG8_LDA(At, 1, 0); PG8_STAGE(PG8_SA(0, 1), a2 + hstep, voffA);
            PG8_WAIT_L(8); PG8_BAR; PG8_WAIT_L(0); PG8_MMA(0, 0, At, B0); PG8_BAR; PG8_SCHED;
            PG8_LDB(B1, 1, 1); PG8_STAGE(PG8_SB(1, 0), b3, voffB);
            PG8_BAR; PG8_WAIT_L(0); PG8_MMA(0, 1, At, B1); PG8_BAR;
            PG8_LDA(At, 1, 1); PG8_STAGE(PG8_SA(1, 0), a3, voffA);
            PG8_BAR; PG8_WAIT_L(0); PG8_MMA(1, 0, At, B0); PG8_BAR; PG8_SCHED;
            PG8_STAGE(PG8_SB(1, 1), b3 + hstep, voffB);
            PG8_WAIT_V(6); PG8_BAR; PG8_MMA(1, 1, At, B1); PG8_BAR;
            }
        }
        if constexpr (ALIGN_EPI) { if (wr == 0) PG8_BAR; }
        if constexpr (!Epi::AFTER_DRAIN) { E(acc, cur, wr, wc, fr, fq); S.done(cur); }
        if (!has_next) break;
#pragma unroll
        for (int a = 0; a < 2; ++a)
#pragma unroll
            for (int b = 0; b < 2; ++b)
#pragma unroll
                for (int m = 0; m < 4; ++m)
#pragma unroll
                    for (int n = 0; n < 2; ++n) acc[a][b][m][n] = (f32x4){0.f, 0.f, 0.f, 0.f};
        cur = nxt; cA = nA; cB = nB; ++ui;
        if constexpr (ALIGN_EPI) { if (wr == 1) PG8_BAR; }
    }
    PG8_WAIT_V(0);
    if constexpr (!ALIGN_EPI) { if (wr == 0) PG8_BAR; }
    PG8_BAR;
    if constexpr (Epi::AFTER_DRAIN) { E.fused(acc, cur, wr, wc, fr, fq, lds, wid, lane); S.done(cur); }
#undef PG8_SA
#undef PG8_SB
#undef PG8_STAGE
#undef PG8_LDA
#undef PG8_LDB
#undef PG8_MMA
#undef PG8_WAIT_V
#undef PG8_WAIT_L
#undef PG8_BAR
#undef PG8_SCHED
}
}

#ifndef MK_N_LAUNCHES
#define MK_N_LAUNCHES 1
#endif
#ifdef DUMP_SRC
#define MK_DUMP 1
#else
#define MK_DUMP 0
#endif
#ifndef PG8_SP2
#define PG8_SP2 true
#endif
#ifndef PG8_ALIGN
#define PG8_ALIGN true
#endif

constexpr int D = 1024, BATCH = 16, SEQ = 2048, M = BATCH * SEQ;
constexpr int INW = 8208, NPROJ = 8192;
constexpr int CONVK = 31, NH = 4, DK = 128, DV = 256, KD = 512, RANK = 16, CHUNK = 64, NCHUNK = SEQ / CHUNK;
constexpr float EPS = 1e-6f;
constexpr int NWAVES = 8, NT = NWAVES * 64;

constexpr size_t MiB = 1u << 20;
constexpr size_t WS_WIN = 1 * MiB, WS_WCO = 17 * MiB, WS_WGO = 19 * MiB, WS_WO = 21 * MiB;
constexpr size_t WS_GLR = 23 * MiB;
constexpr size_t WS_SSQP = 25 * MiB;
constexpr size_t WS_ROWSS = 29 * MiB;
constexpr size_t WS_CTL = 0, CTL_ZERO_BYTES = 131072;
constexpr size_t WS_CNT = 65536;
constexpr size_t WS_SZ = 32 * MiB;
constexpr size_t WS_Q = 96 * MiB;
constexpr size_t WS_K = 128 * MiB;
constexpr size_t WS_V = 160 * MiB;
constexpr size_t WS_SGR = 224 * MiB;
constexpr size_t WS_MC = 288 * MiB;
constexpr size_t WS_MG = 352 * MiB;
constexpr size_t WS_PP = 416 * MiB, WS_PQB = 432 * MiB, WS_PKLT = 464 * MiB, WS_PDEC = 496 * MiB;
constexpr size_t WS_END = 497 * MiB;

constexpr int LDS_BYTES = 147456;
constexpr int LDS_MISC = 147200;

#define LAS __attribute__((address_space(3)))
typedef unsigned short bf16;
typedef float f32x4 __attribute__((ext_vector_type(4)));
typedef float f32x2 __attribute__((ext_vector_type(2)));
typedef short bf16x8 __attribute__((ext_vector_type(8)));
typedef unsigned u32x4 __attribute__((ext_vector_type(4)));
typedef unsigned u32x2 __attribute__((ext_vector_type(2)));

__device__ __forceinline__ float bf2f(unsigned b) { return __uint_as_float(b << 16); }
__device__ __forceinline__ float bflo(unsigned w) { return __uint_as_float(w << 16); }
__device__ __forceinline__ float bfhi(unsigned w) { return __uint_as_float(w & 0xffff0000u); }
typedef __bf16 bf16v2 __attribute__((ext_vector_type(2)));
__device__ __forceinline__ unsigned pk2(float lo, float hi) { return pg8::cvt_pk_bf16(lo, hi); }
__device__ __forceinline__ unsigned short f2bf(float f) { return __builtin_bit_cast(unsigned short, (__bf16)f); }
__device__ __forceinline__ float sigm(float x) { return __builtin_amdgcn_rcpf(1.0f + __expf(-x)); }
#define LDS_BARRIER() do { asm volatile("s_waitcnt lgkmcnt(0)" ::: "memory"); __builtin_amdgcn_s_barrier(); asm volatile("" ::: "memory"); } while (0)
__device__ __forceinline__ float wave_sum(float v) {
#pragma unroll
    for (int o = 1; o < 64; o <<= 1) v += __shfl_xor(v, o);
    return v;
}
__device__ __forceinline__ float reduce16(const float (&v)[16], int lane) {
    float a[8], b[4], c[2], d;
    const bool h5 = lane & 32, h4 = lane & 16, h3 = lane & 8, h2 = lane & 4;
#pragma unroll
    for (int i = 0; i < 8; ++i) { const float mine = h5 ? v[8 + i] : v[i], theirs = h5 ? v[i] : v[8 + i]; a[i] = mine + __shfl_xor(theirs, 32); }
#pragma unroll
    for (int i = 0; i < 4; ++i) { const float mine = h4 ? a[4 + i] : a[i], theirs = h4 ? a[i] : a[4 + i]; b[i] = mine + __shfl_xor(theirs, 16); }
#pragma unroll
    for (int i = 0; i < 2; ++i) { const float mine = h3 ? b[2 + i] : b[i], theirs = h3 ? b[i] : b[2 + i]; c[i] = mine + __shfl_xor(theirs, 8); }
    { const float mine = h2 ? c[1] : c[0], theirs = h2 ? c[0] : c[1]; d = mine + __shfl_xor(theirs, 4); }
    d += __shfl_xor(d, 2); d += __shfl_xor(d, 1);
    return d;
}

__device__ __forceinline__ float reduce8(const float (&v)[8], int lane) {
    float a[4], b[2], c;
    const bool h5 = lane & 32, h4 = lane & 16, h3 = lane & 8;
#pragma unroll
    for (int i = 0; i < 4; ++i) { const float mine = h5 ? v[4 + i] : v[i], theirs = h5 ? v[i] : v[4 + i]; a[i] = mine + __shfl_xor(theirs, 32); }
#pragma unroll
    for (int i = 0; i < 2; ++i) { const float mine = h4 ? a[2 + i] : a[i], theirs = h4 ? a[i] : a[2 + i]; b[i] = mine + __shfl_xor(theirs, 16); }
    { const float mine = h3 ? b[1] : b[0], theirs = h3 ? b[0] : b[1]; c = mine + __shfl_xor(theirs, 8); }
    c += __shfl_xor(c, 4); c += __shfl_xor(c, 2); c += __shfl_xor(c, 1);
    return c;
}

struct EpiProj {
    static constexpr bool PERM = true, AFTER_DRAIN = false;
    bf16* U; unsigned char* ws;
    __device__ __forceinline__ void operator()(const f32x4 (&acc)[2][2][4][2], const pg8::Unit& u, int wr, int wc, int fr, int fq) const {
        const int row0 = u.pm * 256 + wr * 64 + fr, pn = u.pn, cw = wc * 32 + 8 * fq;
        if (pn < 8) {
            bf16* base = U + (size_t)row0 * 1024 + pn * 128 + cw;
#pragma unroll
            for (int ai = 0; ai < 2; ++ai)
#pragma unroll
                for (int m = 0; m < 4; ++m) {
                    f32x4 a0 = acc[ai][0][m][0], a1 = acc[ai][0][m][1]; const f32x4 g0 = acc[ai][1][m][0], g1 = acc[ai][1][m][1];
#pragma unroll
                    for (int e = 0; e < 4; ++e) { a0[e] *= sigm(g0[e]); a1[e] *= sigm(g1[e]); }
                    u32x4 w; w.x = pk2(a0[0], a0[1]); w.y = pk2(a0[2], a0[3]); w.z = pk2(a1[0], a1[1]); w.w = pk2(a1[2], a1[3]);
                    __builtin_nontemporal_store(w, (u32x4*)(base + (size_t)(ai * 128 + m * 16) * 1024)); }
        } else {
            size_t boff; int ld, colt, mode; float sc = 1.f;
            if (pn < 12)      { boff = WS_SZ;  ld = 1024; colt = (pn - 8) * 256;  mode = 0; }
            else if (pn < 14) { boff = WS_Q;   ld = 512;  colt = (pn - 12) * 256; mode = 0; sc = 0.08838834764831845f; }
            else if (pn < 16) { boff = WS_K;   ld = 512;  colt = (pn - 14) * 256; mode = 0; }
            else if (pn < 20) { boff = WS_V;   ld = 1024; colt = (pn - 16) * 256; mode = 0; }
            else if (pn < 24) { boff = WS_SGR; ld = 1024; colt = (pn - 20) * 256; mode = 0; }
            else if (pn < 28) { boff = WS_MC;  ld = 1024; colt = (pn - 24) * 256; mode = 2; }
            else              { boff = WS_MG;  ld = 1024; colt = (pn - 28) * 256; mode = 2; }
            bf16* base = (bf16*)(ws + boff);
            base += (size_t)row0 * ld + colt + cw;
#pragma unroll
            for (int ai = 0; ai < 2; ++ai)
#pragma unroll
                for (int m = 0; m < 4; ++m)
#pragma unroll
                    for (int bj = 0; bj < 2; ++bj) {
                        f32x4 v0 = acc[ai][bj][m][0], v1 = acc[ai][bj][m][1];
                        if (mode == 0) { v0 = v0 * sc; v1 = v1 * sc; }
                        else {
#pragma unroll
                            for (int e = 0; e < 4; ++e) { const float s0 = sigm(v0[e]), s1 = sigm(v1[e]); v0[e] = (mode == 1) ? v0[e] * s0 : s0; v1[e] = (mode == 1) ? v1[e] * s1 : s1; }
                        }
                        u32x4 w; w.x = pk2(v0[0], v0[1]); w.y = pk2(v0[2], v0[3]); w.z = pk2(v1[0], v1[1]); w.w = pk2(v1[2], v1[3]);
                        __builtin_nontemporal_store(w, (u32x4*)(base + (size_t)(ai * 128 + m * 16) * ld + bj * 128)); }
        }
    }
};
struct EpiMul {
    static constexpr bool PERM = true, AFTER_DRAIN = false;
    bf16* O; const bf16* G;
    __device__ __forceinline__ void operator()(const f32x4 (&acc)[2][2][4][2], const pg8::Unit& u, int wr, int wc, int fr, int fq) const {
        const size_t off0 = (size_t)(u.pm * 256 + wr * 64 + fr) * 1024 + u.pn * 256 + wc * 32 + 8 * fq;
#pragma unroll
        for (int ai = 0; ai < 2; ++ai) {
            u32x4 gv[4][2];
#pragma unroll
            for (int m = 0; m < 4; ++m)
#pragma unroll
                for (int bj = 0; bj < 2; ++bj) gv[m][bj] = __builtin_nontemporal_load((const u32x4*)(G + off0 + (size_t)(ai * 128 + m * 16) * 1024 + bj * 128));
#pragma unroll
            for (int m = 0; m < 4; ++m)
#pragma unroll
                for (int bj = 0; bj < 2; ++bj) {
                    const size_t off = off0 + (size_t)(ai * 128 + m * 16) * 1024 + bj * 128;
                    const u32x4 g = gv[m][bj]; const f32x4 v0 = acc[ai][bj][m][0], v1 = acc[ai][bj][m][1];
                    u32x4 w; w.x = pk2(v0[0] * bflo(g.x), v0[1] * bfhi(g.x)); w.y = pk2(v0[2] * bflo(g.y), v0[3] * bfhi(g.y));
                    w.z = pk2(v1[0] * bflo(g.z), v1[1] * bfhi(g.z)); w.w = pk2(v1[2] * bflo(g.w), v1[3] * bfhi(g.w));
                    *(u32x4*)(O + off) = w; }
        }
    }
};
struct EpiMerge {
    static constexpr bool PERM = true, AFTER_DRAIN = false;
    bf16* O; const bf16* C; const bf16* G;
    __device__ __forceinline__ void operator()(const f32x4 (&acc)[2][2][4][2], const pg8::Unit& u, int wr, int wc, int fr, int fq) const {
        const size_t off0 = (size_t)(u.pm * 256 + wr * 64 + fr) * 1024 + u.pn * 256 + wc * 32 + 8 * fq;
#pragma unroll
        for (int ai = 0; ai < 2; ++ai) {
            u32x4 gv[4][2], cv[4][2];
#pragma unroll
            for (int m = 0; m < 4; ++m)
#pragma unroll
                for (int bj = 0; bj < 2; ++bj) { const size_t off = off0 + (size_t)(ai * 128 + m * 16) * 1024 + bj * 128; gv[m][bj] = __builtin_nontemporal_load((const u32x4*)(G + off)); cv[m][bj] = __builtin_nontemporal_load((const u32x4*)(C + off)); }
#pragma unroll
            for (int m = 0; m < 4; ++m)
#pragma unroll
                for (int bj = 0; bj < 2; ++bj) {
                    const size_t off = off0 + (size_t)(ai * 128 + m * 16) * 1024 + bj * 128;
                    const u32x4 g = gv[m][bj], c = cv[m][bj]; const f32x4 v0 = acc[ai][bj][m][0], v1 = acc[ai][bj][m][1];
                    u32x4 w; w.x = pk2(bflo(c.x) + v0[0] * bflo(g.x), bfhi(c.x) + v0[1] * bfhi(g.x)); w.y = pk2(bflo(c.y) + v0[2] * bflo(g.y), bfhi(c.y) + v0[3] * bfhi(g.y));
                    w.z = pk2(bflo(c.z) + v1[0] * bflo(g.z), bfhi(c.z) + v1[1] * bfhi(g.z)); w.w = pk2(bflo(c.w) + v1[2] * bflo(g.w), bfhi(c.w) + v1[3] * bfhi(g.w));
                    *(u32x4*)(O + off) = w; }
        }
    }
};
struct EpiRes {
    static constexpr bool PERM = false, AFTER_DRAIN = false;
    float* out; const float* X; float* SS;
    __device__ __forceinline__ void operator()(const f32x4 (&acc)[2][2][4][2], const pg8::Unit& u, int wr, int wc, int fr, int fq) const {
        const int row0 = u.pm * 256 + wr * 64 + fr, col0 = u.pn * 256 + wc * 32 + 4 * fq;
#pragma unroll
        for (int ai = 0; ai < 2; ++ai)
#pragma unroll
            for (int m = 0; m < 4; ++m) {
                const int row = row0 + ai * 128 + m * 16; const size_t off = (size_t)row * 1024 + col0; float s = 0.f;
#pragma unroll
                for (int bj = 0; bj < 2; ++bj)
#pragma unroll
                    for (int n = 0; n < 2; ++n) { const f32x4 r = *(const f32x4*)(X + off + bj * 128 + n * 16) + acc[ai][bj][m][n]; *(f32x4*)(out + off + bj * 128 + n * 16) = r;
                        s += (r[0] * r[0] + r[1] * r[1]) + (r[2] * r[2] + r[3] * r[3]); }
                s += __shfl_xor(s, 16); s += __shfl_xor(s, 32);
                if (fq == 0) SS[((size_t)u.pn * M + row) * 4 + wc] = s; }
    }
};

struct EpiBranches {
    static constexpr bool PERM = true, AFTER_DRAIN = false;
    bf16* Y; bf16* YCM; const bf16* MC; const bf16* MG;
    __device__ __forceinline__ void operator()(const f32x4 (&acc)[2][2][4][2], const pg8::Unit& u, int wr, int wc, int fr, int fq) const {
        if (u.pn < 4) { EpiMul e{YCM, MC}; e(acc, u, wr, wc, fr, fq); }
        else { pg8::Unit v; v.pm = u.pm - M / 256; v.pn = u.pn - 4; EpiMerge e{Y, YCM, MG}; e(acc, v, wr, wc, fr, fq); }
    }
};
struct BranchOrder {
    pg8::StaticOrder base; int nb;
    __device__ __forceinline__ void init(int G, int c) { base.init(M, D, G, c); nb = (base.nwg - c + G - 1) / G; }
    __device__ __forceinline__ bool next(int i, pg8::Unit& u) const { const int s = (i >= nb) ? 1 : 0, j = i - s * nb; if (j >= nb) return false; const bool ok = base.next(j, u); u.pm += s * (M / 256); u.pn += s * 4; return ok; }
    __device__ __forceinline__ void a_ready(const pg8::Unit&) const {}
    __device__ __forceinline__ void done(const pg8::Unit&) const {}
};

struct EpiResNorm {
    static constexpr bool PERM = false, AFTER_DRAIN = true;
    float* out; const float* X; const float* Gn; float* slots; unsigned* cnt;
    __device__ __forceinline__ void fused(f32x4 (&acc)[2][2][4][2], const pg8::Unit& u, int wr, int wc, int fr, int fq, PG8_LAS unsigned char* lds, int wid, int lane) const {
        PG8_LAS float* Pt = (PG8_LAS float*)lds;
        PG8_LAS float* St = (PG8_LAS float*)(lds + 4096);
        const int tid = wid * 64 + lane, col0 = u.pn * 256 + wc * 32 + 4 * fq;
#pragma unroll
        for (int ai = 0; ai < 2; ++ai)
#pragma unroll
            for (int m = 0; m < 4; ++m) {
                const int rl = ai * 128 + wr * 64 + m * 16 + fr; const size_t off = (size_t)(u.pm * 256 + rl) * 1024 + col0; float s = 0.f;
#pragma unroll
                for (int bj = 0; bj < 2; ++bj)
#pragma unroll
                    for (int n = 0; n < 2; ++n) { const f32x4 r = __builtin_nontemporal_load((const f32x4*)(X + off + bj * 128 + n * 16)) + acc[ai][bj][m][n]; acc[ai][bj][m][n] = r;
                        s += (r[0] * r[0] + r[1] * r[1]) + (r[2] * r[2] + r[3] * r[3]); }
                s += __shfl_xor(s, 16); s += __shfl_xor(s, 32);
                if (fq == 0) Pt[rl * 4 + wc] = s; }
        __syncthreads();
        if (tid < 256) { const f32x4 p = *(const PG8_LAS f32x4*)(Pt + tid * 4); __hip_atomic_store(slots + ((size_t)u.pm * 4 + u.pn) * 256 + tid, (p[0] + p[1]) + (p[2] + p[3]), __ATOMIC_RELAXED, __HIP_MEMORY_SCOPE_AGENT); }
        asm volatile("s_waitcnt vmcnt(0)" ::: "memory");
        __syncthreads();
        if (tid == 0) {
            unsigned* c = cnt + u.pm * 64;
            (void)__hip_atomic_fetch_add(c, 1u, __ATOMIC_RELAXED, __HIP_MEMORY_SCOPE_AGENT);
            unsigned spins = 0;
            while (__hip_atomic_load(c, __ATOMIC_RELAXED, __HIP_MEMORY_SCOPE_AGENT) < 4u) { __builtin_amdgcn_s_sleep(1); if (++spins > (1u << 24)) break; }
        }
        __syncthreads();
        if (tid < 256) { float ssq = 0.f;
#pragma unroll
            for (int q = 0; q < 4; ++q) ssq += __hip_atomic_load(slots + ((size_t)u.pm * 4 + q) * 256 + tid, __ATOMIC_RELAXED, __HIP_MEMORY_SCOPE_AGENT);
            St[tid] = 1.0f / sqrtf(ssq * (1.0f / 1024.0f) + 1e-6f); }
        __syncthreads();
#pragma unroll
        for (int ai = 0; ai < 2; ++ai)
#pragma unroll
            for (int m = 0; m < 4; ++m) {
                const int rl = ai * 128 + wr * 64 + m * 16 + fr; const size_t off = (size_t)(u.pm * 256 + rl) * 1024 + col0; const float rstd = St[rl];
#pragma unroll
                for (int bj = 0; bj < 2; ++bj)
#pragma unroll
                    for (int n = 0; n < 2; ++n) { const f32x4 g4 = *(const f32x4*)(Gn + col0 + bj * 128 + n * 16); __builtin_nontemporal_store(acc[ai][bj][m][n] * rstd * g4, (f32x4*)(out + off + bj * 128 + n * 16)); } }
        __syncthreads();
    }
};
struct HalfOrder : pg8::StaticOrder {
    int pmoff;
    __device__ __forceinline__ bool next(int i, pg8::Unit& u) const { const bool ok = pg8::StaticOrder::next(i, u); u.pm += pmoff; return ok; }
};

struct Args { const float* in[14]; float* out; unsigned char* ws; int ph_lo, ph_hi; };

__device__ __forceinline__ int srcmap(int n) {
    if (n < 2048) { const int pn = n >> 8, i = n & 255; return (i < 128) ? (128 * pn + i) : (1024 + 128 * pn + (i - 128)); }
    return (n < 5120) ? n : n + 16;
}
__device__ __forceinline__ void transpose_item(const float* W, int ldw, int src0, bf16* WT, int K, int dst0, int k0, LAS float* scr, int lane) {
#pragma unroll 8
    for (int i = 0; i < 32; ++i) { const int kk = 2 * i + (lane >> 5); scr[kk * 33 + (lane & 31)] = __builtin_nontemporal_load(W + (size_t)(k0 + kk) * ldw + src0 + (lane & 31)); }
    asm volatile("s_waitcnt lgkmcnt(0)" ::: "memory");
    const int c = lane & 7;
#pragma unroll
    for (int j = 0; j < 4; ++j) { const int n = (lane >> 3) + 8 * j; const LAS float* s = scr + (8 * c) * 33 + n;
        u32x4 o; o.x = pk2(s[0 * 33], s[1 * 33]); o.y = pk2(s[2 * 33], s[3 * 33]); o.z = pk2(s[4 * 33], s[5 * 33]); o.w = pk2(s[6 * 33], s[7 * 33]);
        *(u32x4*)(WT + (size_t)(dst0 + n) * K + k0 + 8 * c) = o; }
    asm volatile("s_waitcnt lgkmcnt(0)" ::: "memory");
}

#define XB_TMO      128
#define XB_XCNT(j)  (256  + 64 * (j))
#define XB_XSUB(j)  (1280 + 64 * (j))
#define XB_XGEN(j)  (2304 + 64 * (j))
#define XB_TOP      3328
#define XB_TOPGEN   3392
#define XCD_BAR_WORDS 3456
#define XB_SPIN_CAP (1u << 18)

__device__ __forceinline__ unsigned xb_ld(unsigned* p)              { return __hip_atomic_load(p, __ATOMIC_RELAXED, __HIP_MEMORY_SCOPE_AGENT); }
__device__ __forceinline__ unsigned xb_add(unsigned* p, unsigned v) { return __hip_atomic_fetch_add(p, v, __ATOMIC_RELAXED, __HIP_MEMORY_SCOPE_AGENT); }
__device__ __forceinline__ unsigned xb_xcc_id() { return (unsigned)__builtin_amdgcn_s_getreg((3 << 11) | 20) & 0xFu; }
#define XB_SPIN(cond, bar) do { unsigned _sp = 0; while (cond) { __builtin_amdgcn_s_sleep(1); \
    if ((++_sp & 255u) == 0u) { if (xb_ld(&(bar)[XB_TMO])) break; if (_sp > XB_SPIN_CAP) { atomicAdd(&(bar)[XB_TMO], 1u); break; } } } } while (0)

struct XcdBarrier {
    unsigned* bar; unsigned x;
    volatile LAS unsigned* st;
};

__device__ __forceinline__ XcdBarrier xcd_barrier_post(unsigned* bar, volatile LAS unsigned* st) {
    XcdBarrier b; b.bar = bar; b.x = xb_xcc_id(); b.st = st;
    if (threadIdx.x == 0) st[2] = xb_add(&bar[XB_XCNT(b.x)], 1u);
    return b;
}
__device__ __forceinline__ void xcd_barrier_complete(unsigned* bar, unsigned x, unsigned& nloc, unsigned& nx) {
    const unsigned G = gridDim.x * gridDim.y * gridDim.z;
    unsigned sum, cnt, mine, sp = 0u;
    for (;;) {
        sum = 0u; cnt = 0u; mine = 0u;
#pragma unroll
        for (unsigned j = 0; j < 16; ++j) { const unsigned c = xb_ld(&bar[XB_XCNT(j)]); sum += c; cnt += (c > 0u) ? 1u : 0u; mine = (j == x) ? c : mine; }
        if (sum == G) break;
        __builtin_amdgcn_s_sleep(1);
        if ((++sp & 255u) == 0u) { if (xb_ld(&bar[XB_TMO])) break; if (sp > XB_SPIN_CAP) { atomicAdd(&bar[XB_TMO], 1u); break; } }
    }
    nloc = mine > 0u ? mine : 1u; nx = cnt > 0u ? cnt : 1u;
}

__device__ __forceinline__ void xcd_barrier(const XcdBarrier& b) {
    asm volatile("s_waitcnt vmcnt(0)" ::: "memory");
    __syncthreads();
    if (threadIdx.x == 0) {
        unsigned* bar = b.bar;
        __builtin_amdgcn_s_waitcnt(0);
        unsigned nloc = b.st[0], nx = b.st[1];
        if (nloc == 0u) { xcd_barrier_complete(bar, b.x, nloc, nx); b.st[0] = nloc; b.st[1] = nx; }
        const unsigned old = xb_add(&bar[XB_XSUB(b.x)], 1u);
        const unsigned gen = old / nloc;
        if (old + 1u == (gen + 1u) * nloc) {
            __builtin_amdgcn_fence(__ATOMIC_RELEASE, "agent");
            asm volatile("s_waitcnt vmcnt(0)" ::: "memory");
            const unsigned og = xb_add(&bar[XB_TOP], 1u);
            const unsigned tg = og / nx;
            if (og + 1u == (tg + 1u) * nx) xb_add(&bar[XB_TOPGEN], 1u);
            else XB_SPIN(xb_ld(&bar[XB_TOPGEN]) == tg, bar);
            __builtin_amdgcn_fence(__ATOMIC_ACQUIRE, "agent");
            xb_add(&bar[XB_XGEN(b.x)], 1u);
            asm volatile("s_waitcnt vmcnt(0)" ::: "memory");
        } else {
            XB_SPIN(xb_ld(&bar[XB_XGEN(b.x)]) == gen, bar);
            __builtin_amdgcn_fence(__ATOMIC_ACQUIRE, "agent");
            asm volatile("s_waitcnt vmcnt(0)" ::: "memory");
        }
    }
    __syncthreads();
}


__device__ __forceinline__ void p0_prologue(LAS unsigned char* lds, const int tid, const int lane, const int wave, const int gw, const int NGW,
        const float* x, const float* norm_g, const float* w_in, const float* w_co, const float* w_go, const float* w_o,
        bf16* WinT, bf16* WcoT, bf16* WgoT, bf16* WoT, bf16* H, float* GLR) {
    LAS float* wT = (LAS float*)lds;
    LAS float* scr = (LAS float*)(lds + 65536 + wave * 8448);
    for (int idx = tid; idx < 4096; idx += NT) { const int k = idx >> 2, r4 = idx & 3; const f32x4 w = *(const f32x4*)(w_in + (size_t)k * INW + 5120 + 4 * r4);
        wT[(4 * r4 + 0) * 1024 + k] = w[0]; wT[(4 * r4 + 1) * 1024 + k] = w[1]; wT[(4 * r4 + 2) * 1024 + k] = w[2]; wT[(4 * r4 + 3) * 1024 + k] = w[3]; }
    constexpr int I_IN = 16 * 256, I_SQ = 16 * 32, NITEMS = I_IN + 3 * I_SQ;
    for (int it = gw; it < NITEMS; it += NGW) {
        int r = it;
        if (r < I_IN) { const int nb = r >> 4, kb = r & 15; transpose_item(w_in, INW, srcmap(32 * nb), WinT, D, 32 * nb, 64 * kb, scr, lane); continue; } r -= I_IN;
        const float* W = (r < I_SQ) ? w_co : (r < 2 * I_SQ) ? w_go : w_o; bf16* WT = (r < I_SQ) ? WcoT : (r < 2 * I_SQ) ? WgoT : WoT; r &= (I_SQ - 1);
        const int nb = r >> 4, kb = r & 15; transpose_item(W, D, 32 * nb, WT, D, 32 * nb, 64 * kb, scr, lane);
    }
    __syncthreads();
    f32x4 g[4];
#pragma unroll
    for (int j = 0; j < 4; ++j) g[j] = *(const f32x4*)(norm_g + 256 * j + 4 * lane);
    for (int mp = gw; mp < M / 2; mp += NGW) {
        const int m = 2 * mp;
        const f32x4* xr = (const f32x4*)(x + (size_t)m * D) + lane;
        f32x4 v0[4], v1[4]; float s0 = 0.f, s1 = 0.f;
#pragma unroll
        for (int j = 0; j < 4; ++j) { v0[j] = __builtin_nontemporal_load(xr + 64 * j); v1[j] = __builtin_nontemporal_load(xr + 256 + 64 * j);
            s0 += (v0[j][0] * v0[j][0] + v0[j][1] * v0[j][1]) + (v0[j][2] * v0[j][2] + v0[j][3] * v0[j][3]);
            s1 += (v1[j][0] * v1[j][0] + v1[j][1] * v1[j][1]) + (v1[j][2] * v1[j][2] + v1[j][3] * v1[j][3]); }
        const float r0 = 1.0f / sqrtf(wave_sum(s0) * (1.0f / D) + EPS), r1 = 1.0f / sqrtf(wave_sum(s1) * (1.0f / D) + EPS);
        unsigned long long* o8 = (unsigned long long*)(H + (size_t)m * D) + lane;
#pragma unroll
        for (int j = 0; j < 4; ++j) { v0[j] = v0[j] * r0 * g[j]; v1[j] = v1[j] * r1 * g[j];
            o8[64 * j] = (unsigned long long)pk2(v0[j][0], v0[j][1]) | ((unsigned long long)pk2(v0[j][2], v0[j][3]) << 32);
            o8[256 + 64 * j] = (unsigned long long)pk2(v1[j][0], v1[j][1]) | ((unsigned long long)pk2(v1[j][2], v1[j][3]) << 32); }
        float p0[16], p1[16];
#pragma unroll
        for (int r = 0; r < 16; ++r) { float a0 = 0.f, a1 = 0.f;
#pragma unroll
            for (int j = 0; j < 4; ++j) { const f32x4 w = *(const LAS f32x4*)(wT + r * 1024 + 256 * j + 4 * lane);
                a0 += (v0[j][0] * w[0] + v0[j][1] * w[1]) + (v0[j][2] * w[2] + v0[j][3] * w[3]); a1 += (v1[j][0] * w[0] + v1[j][1] * w[1]) + (v1[j][2] * w[2] + v1[j][3] * w[3]); }
            p0[r] = a0; p1[r] = a1; }
        const float t0 = reduce16(p0, lane), t1 = reduce16(p1, lane);
        if ((lane & 3) == 0) { GLR[(size_t)m * 16 + (lane >> 2)] = t0; GLR[(size_t)m * 16 + 16 + (lane >> 2)] = t1; }
    }
}

__device__ __forceinline__ void conv_tile(LAS unsigned char* lds, const int tid, const int lane, const int wave, const int tile,
        const float* conv_w, const float* conv_b, const float* ln_g, const float* ln_b, const bf16* U, const bf16* SZ, bf16* UC) {
    constexpr int TT = 128, GRP = 4;
    LAS float* red = (LAS float*)lds;
    const int c0 = 2 * tid, t0 = tile * TT;
    f32x2 w[CONVK];
#pragma unroll
    for (int j = 0; j < CONVK; ++j) w[j] = *(const f32x2*)(conv_w + j * D + c0);
    const f32x2 cb = *(const f32x2*)(conv_b + c0), lg = *(const f32x2*)(ln_g + c0), lb = *(const f32x2*)(ln_b + c0);
    f32x2 win[CONVK - 1 + GRP];
    const bool seq_start = (t0 % SEQ) == 0;
#pragma unroll
    for (int j = 0; j < CONVK - 1; ++j) {
        unsigned uv = 0u; if (!seq_start) uv = *(const unsigned*)(U + (size_t)(t0 - (CONVK - 1) + j) * D + c0);
        win[j] = (f32x2){bflo(uv), bfhi(uv)}; }
    unsigned nxt[GRP], sznxt[GRP];
#pragma unroll
    for (int i = 0; i < GRP; ++i) { nxt[i] = __builtin_nontemporal_load((const unsigned*)(U + (size_t)(t0 + i) * D + c0)); sznxt[i] = __builtin_nontemporal_load((const unsigned*)(SZ + (size_t)(t0 + i) * D + c0)); }
    for (int gi = 0; gi < TT / GRP; ++gi) {
        const int tg = t0 + gi * GRP;
        unsigned szv[GRP];
#pragma unroll
        for (int i = 0; i < GRP; ++i) { win[CONVK - 1 + i] = (f32x2){bflo(nxt[i]), bfhi(nxt[i])}; szv[i] = sznxt[i]; }
        if (gi + 1 < TT / GRP) {
#pragma unroll
            for (int i = 0; i < GRP; ++i) { nxt[i] = __builtin_nontemporal_load((const unsigned*)(U + (size_t)(tg + GRP + i) * D + c0)); sznxt[i] = __builtin_nontemporal_load((const unsigned*)(SZ + (size_t)(tg + GRP + i) * D + c0)); }
        }
        f32x2 cv[GRP]; float st[2 * GRP];
#pragma unroll
        for (int i = 0; i < GRP; ++i) { f32x2 a = cb;
#pragma unroll
            for (int j = 0; j < CONVK; ++j) a = w[j] * win[i + j] + a;
            cv[i] = a; st[2 * i] = a[0] + a[1]; st[2 * i + 1] = a[0] * a[0] + a[1] * a[1]; }
#pragma unroll
        for (int j = 0; j < CONVK - 1; ++j) win[j] = win[j + GRP];
        const float tot = reduce8(st, lane);
        LAS float* rb = red + (gi & 1) * 64;
        if ((lane & 7) == 0) rb[wave * 8 + (lane >> 3)] = tot;
        LDS_BARRIER();
        float pv = rb[lane];
        pv += __shfl_xor(pv, 8); pv += __shfl_xor(pv, 16); pv += __shfl_xor(pv, 32);
#pragma unroll
        for (int i = 0; i < GRP; ++i) {
            const float s1 = __int_as_float(__builtin_amdgcn_readlane(__float_as_int(pv), 2 * i)), s2 = __int_as_float(__builtin_amdgcn_readlane(__float_as_int(pv), 2 * i + 1));
            const float mu = s1 * (1.0f / D), var = fmaxf(s2 * (1.0f / D) - mu * mu, 0.f), rstd = __builtin_amdgcn_rsqf(var + EPS);
            float y0 = (cv[i][0] - mu) * rstd * lg[0] + lb[0], y1 = (cv[i][1] - mu) * rstd * lg[1] + lb[1];
            const float z0 = bflo(szv[i]), z1 = bfhi(szv[i]);
            y0 = y0 * sigm(y0) * (z0 * sigm(z0)); y1 = y1 * sigm(y1) * (z1 * sigm(z1));
            __builtin_nontemporal_store(pk2(y0, y1), (unsigned*)(UC + (size_t)(tg + i) * D + c0));
        }
    }
    LDS_BARRIER();
}

constexpr int S128 = 272, S64 = 144;
constexpr int L_QE = 0, L_KE = 17408, L_QB = 34816, L_KLT = 52224, L_VT = 70656, L_P = 79872, L_ST = 89088, L_GLR = 106496, L_SEG = 110592, L_DEC = 112640;
__device__ __forceinline__ void gla_prepass(LAS unsigned char* L, const int tid, const int lane, const int wave, const int pb, const int h, const int n0, const int nu,
        const float* gate_w2, const float* gate_b, const bf16* Q, const bf16* Kb, const float* GLR, bf16* Pg, bf16* QBg, bf16* KLTg, float* DECg) {
    const int d = tid & 127, seg = tid >> 7, lr = lane & 15, lg = lane >> 4;
    const int qrow0 = tid >> 4, qcu = tid & 15, grow = tid >> 2, gcu = tid & 3;
    u32x4 rq[2], rk[2]; f32x4 rg = (f32x4){0.f, 0.f, 0.f, 0.f};
#define PP_LOAD(u) do { const int h_ = h; const size_t t0_ = (size_t)((u) >> 2) * CHUNK; \
        _Pragma("unroll") for (int i = 0; i < 2; ++i) { rq[i] = __builtin_nontemporal_load((const u32x4*)(Q + (t0_ + qrow0 + 32 * i) * KD + h_ * DK + qcu * 8)); rk[i] = __builtin_nontemporal_load((const u32x4*)(Kb + (t0_ + qrow0 + 32 * i) * KD + h_ * DK + qcu * 8)); } \
        if (tid < 256) rg = *(const f32x4*)(GLR + (t0_ + grow) * 16 + gcu * 4); } while (0)
#define PP_STORE() do { \
        _Pragma("unroll") for (int i = 0; i < 2; ++i) { *(LAS u32x4*)(L + L_QE + (qrow0 + 32 * i) * S128 + qcu * 16) = rq[i]; *(LAS u32x4*)(L + L_KE + (qrow0 + 32 * i) * S128 + qcu * 16) = rk[i]; } \
        if (tid < 256) *(LAS f32x4*)(L + L_GLR + grow * 64 + gcu * 16) = rg; } while (0)
    const int u0 = (pb * NCHUNK + n0) * NH + h;
    float w2[16];
#pragma unroll
    for (int r = 0; r < 16; ++r) w2[r] = gate_w2[r * KD + h * DK + d];
    const float gb = gate_b[h * DK + d];
    PP_LOAD(u0);
    PP_STORE();
    LDS_BARRIER();
    for (int ui = 0; ui < nu; ++ui) {
        const int u = u0 + 4 * ui;
        if (ui + 1 < nu) PP_LOAD(u + 4);
        float bb[16]; float run = 0.f;
#pragma unroll
        for (int i = 0; i < 16; ++i) {
            const LAS f32x4* gp = (const LAS f32x4*)(L + L_GLR + (seg * 16 + i) * 64);
            float z = gb;
#pragma unroll
            for (int r4 = 0; r4 < 4; ++r4) { const f32x4 gv = gp[r4]; z += (gv[0] * w2[4 * r4] + gv[1] * w2[4 * r4 + 1]) + (gv[2] * w2[4 * r4 + 2] + gv[3] * w2[4 * r4 + 3]); }
            const float ls = fminf(z, 0.f) - 0.6931471805599453f * __builtin_amdgcn_logf(1.0f + __expf(-fabsf(z)));
            run += ls * (1.0f / 16.0f); bb[i] = run; }
        ((LAS float*)(L + L_SEG))[seg * 128 + d] = run;
        LDS_BARRIER();
        float offs = 0.f, ref, last;
        { const LAS float* sp = (const LAS float*)(L + L_SEG); const float s0 = sp[d], s1 = sp[128 + d], s2 = sp[256 + d], s3 = sp[384 + d];
          ref = s0 + s1; last = (s0 + s1) + (s2 + s3); offs = (seg == 0) ? 0.f : (seg == 1) ? s0 : (seg == 2) ? (s0 + s1) : (s0 + s1) + s2; }
        unsigned klt[8]; const float eref = __expf(ref), elr = __expf(last - ref);
#pragma unroll
        for (int i = 0; i < 16; ++i) {
            const int t = seg * 16 + i; const float bt = bb[i] + offs;
            LAS unsigned short* qp = (LAS unsigned short*)(L + L_QE + t * S128 + d * 2); LAS unsigned short* kp = (LAS unsigned short*)(L + L_KE + t * S128 + d * 2);
            const float q = bf2f(*qp), k = bf2f(*kp);
            const float e1 = __expf(bt - ref), e2 = __expf(ref - bt), e3 = e1 * eref, e4 = e2 * elr;
            *qp = f2bf(q * e1); *kp = f2bf(k * e2);
            *(LAS unsigned short*)(L + L_QB + t * S128 + d * 2) = f2bf(q * e3);
            const unsigned kl = f2bf(k * e4);
            if (i & 1) klt[i >> 1] |= kl << 16; else klt[i >> 1] = kl; }
        { LAS u32x4* kd = (LAS u32x4*)(L + L_KLT + d * S64 + seg * 32); kd[0] = (u32x4){klt[0], klt[1], klt[2], klt[3]}; kd[1] = (u32x4){klt[4], klt[5], klt[6], klt[7]}; }
        if (seg == 0) DECg[(size_t)u * 128 + d] = __expf(last);
        LDS_BARRIER();
        { const int ti = wave >> 1;
#pragma unroll
          for (int tjj = 0; tjj < 2; ++tjj) { const int tj = 2 * (wave & 1) + tjj; f32x4 a = (f32x4){0.f, 0.f, 0.f, 0.f};
            if (tj <= ti) {
#pragma unroll
                for (int ks = 0; ks < 4; ++ks) { const bf16x8 af = *(const LAS bf16x8*)(L + L_QE + (16 * ti + lr) * S128 + (ks * 32 + 8 * lg) * 2), bfm = *(const LAS bf16x8*)(L + L_KE + (16 * tj + lr) * S128 + (ks * 32 + 8 * lg) * 2);
                    a = __builtin_amdgcn_mfma_f32_16x16x32_bf16(af, bfm, a, 0, 0, 0); } }
            const int jg = 16 * tj + lr;
#pragma unroll
            for (int r = 0; r < 4; ++r) { const int ig = 16 * ti + 4 * lg + r; *(LAS unsigned short*)(L + L_P + ig * S64 + jg * 2) = f2bf((jg <= ig) ? a[r] : 0.f); } } }
        LDS_BARRIER();
        { const int prow = tid >> 3, pcu = tid & 7;
          *(u32x4*)(Pg + (size_t)u * 4096 + prow * 64 + pcu * 8) = *(const LAS u32x4*)(L + L_P + prow * S64 + pcu * 16);
#pragma unroll
          for (int i = 0; i < 2; ++i) { const int idx = tid + 512 * i;
            *(u32x4*)(QBg + (size_t)u * 8192 + (idx >> 4) * 128 + (idx & 15) * 8) = *(const LAS u32x4*)(L + L_QB + (idx >> 4) * S128 + (idx & 15) * 16);
            *(u32x4*)(KLTg + (size_t)u * 8192 + (idx >> 3) * 64 + (idx & 7) * 8) = *(const LAS u32x4*)(L + L_KLT + (idx >> 3) * S64 + (idx & 7) * 16); } }
        if (ui + 1 < nu) PP_STORE();
        LDS_BARRIER();
    }
#undef PP_LOAD
#undef PP_STORE
}

__device__ __forceinline__ void gla_chain(LAS unsigned char* L, const int tid, const int lane, const int wave, const int chain,
        const bf16* V, const bf16* Pg, const bf16* QBg, const bf16* KLTg, const float* DECg, bf16* O, float* SSQP, unsigned* cnt, const float* gn_g, const bf16* SGR, bf16* OG) {
    constexpr int C_P = 0, C_QB = 9216, C_KLT = 26624, C_VT = 45056, C_DEC = 54272, C_BUF = 55296, C_ST = 110592, C_SQ = C_ST + 17408;
    static_assert(C_SQ + 2 * SEQ * 4 <= LDS_MISC, "chain LDS map");
    const int vs = chain & 3, h = (chain >> 2) & 3, b = chain >> 4;
    const int lr = lane & 15, lg = lane >> 4;
    f32x4 stacc[4];
#pragma unroll
    for (int c = 0; c < 4; ++c) stacc[c] = (f32x4){0.f, 0.f, 0.f, 0.f};
    for (int i = tid; i < 17408 / 4; i += NT) ((LAS unsigned*)(L + C_ST))[i] = 0u;
    const int prow = tid >> 3, pcu = tid & 7;
    const int qrow0 = tid >> 4, qcu = tid & 15;
    const size_t tokb = (size_t)b * SEQ;
    LAS float* const sq = (LAS float*)(L + C_SQ);
    u32x4 rp, rqb[2], rkl[2], rv; f32x4 rdec = (f32x4){0.f, 0.f, 0.f, 0.f};
#define CH_LOAD(n) do { const size_t u_ = (size_t)((b * NCHUNK + (n)) * NH + h); \
        rp = __builtin_nontemporal_load((const u32x4*)(Pg + u_ * 4096 + prow * 64 + pcu * 8)); \
        _Pragma("unroll") for (int i = 0; i < 2; ++i) { rqb[i] = __builtin_nontemporal_load((const u32x4*)(QBg + u_ * 8192 + (qrow0 + 32 * i) * 128 + qcu * 8)); rkl[i] = __builtin_nontemporal_load((const u32x4*)(KLTg + u_ * 8192 + (prow + 64 * i) * 64 + pcu * 8)); } \
        rv = __builtin_nontemporal_load((const u32x4*)(V + (tokb + (size_t)(n) * CHUNK + prow) * D + h * DV + vs * 64 + pcu * 8)); \
        rdec = *(const f32x4*)(DECg + u_ * 128 + (tid & 31) * 4); } while (0)
#define CH_STORE(B) do { \
        *(LAS u32x4*)((B) + C_P + prow * S64 + pcu * 16) = rp; \
        _Pragma("unroll") for (int i = 0; i < 2; ++i) { *(LAS u32x4*)((B) + C_QB + (qrow0 + 32 * i) * S128 + qcu * 16) = rqb[i]; *(LAS u32x4*)((B) + C_KLT + (prow + 64 * i) * S64 + pcu * 16) = rkl[i]; } \
        { const unsigned vv[4] = {rv.x, rv.y, rv.z, rv.w}; \
          _Pragma("unroll") for (int e = 0; e < 4; ++e) { *(LAS unsigned short*)((B) + C_VT + (pcu * 8 + 2 * e) * S64 + prow * 2) = (unsigned short)(vv[e] & 0xffffu); \
                                                         *(LAS unsigned short*)((B) + C_VT + (pcu * 8 + 2 * e + 1) * S64 + prow * 2) = (unsigned short)(vv[e] >> 16); } } \
        *(LAS f32x4*)((B) + C_DEC + (tid & 31) * 16) = rdec; } while (0)
    CH_LOAD(0);
    CH_STORE(L);
    CH_LOAD(1);
    __syncthreads();
    for (int n = 0; n < NCHUNK; ++n) {
        LAS unsigned char* const Bc = L + (n & 1) * C_BUF; LAS unsigned char* const Bn = L + ((n & 1) ^ 1) * C_BUF;
        LAS unsigned char* const Sc = L + C_ST;
        const size_t tok0 = tokb + (size_t)n * CHUNK;
        if (n + 1 < NCHUNK) { CH_STORE(Bn); if (n + 2 < NCHUNK) CH_LOAD(n + 2); }
        { const int ti = wave & 3, tv0 = 2 * (wave >> 2); f32x4 a0 = (f32x4){0.f, 0.f, 0.f, 0.f}, a1 = a0;
#pragma unroll
          for (int ks = 0; ks < 2; ++ks) { const bf16x8 af = *(const LAS bf16x8*)(Bc + C_P + (16 * ti + lr) * S64 + (ks * 32 + 8 * lg) * 2);
            const bf16x8 b0 = *(const LAS bf16x8*)(Bc + C_VT + (16 * tv0 + lr) * S64 + (ks * 32 + 8 * lg) * 2), b1 = *(const LAS bf16x8*)(Bc + C_VT + (16 * tv0 + 16 + lr) * S64 + (ks * 32 + 8 * lg) * 2);
            a0 = __builtin_amdgcn_mfma_f32_16x16x32_bf16(b0, af, a0, 0, 0, 0); a1 = __builtin_amdgcn_mfma_f32_16x16x32_bf16(b1, af, a1, 0, 0, 0); }
#pragma unroll
          for (int ks = 0; ks < 4; ++ks) { const bf16x8 af = *(const LAS bf16x8*)(Bc + C_QB + (16 * ti + lr) * S128 + (ks * 32 + 8 * lg) * 2);
            const bf16x8 b0 = *(const LAS bf16x8*)(Sc + (16 * tv0 + lr) * S128 + (ks * 32 + 8 * lg) * 2), b1 = *(const LAS bf16x8*)(Sc + (16 * tv0 + 16 + lr) * S128 + (ks * 32 + 8 * lg) * 2);
            a0 = __builtin_amdgcn_mfma_f32_16x16x32_bf16(b0, af, a0, 0, 0, 0); a1 = __builtin_amdgcn_mfma_f32_16x16x32_bf16(b1, af, a1, 0, 0, 0); }
          { bf16* op = O + (tok0 + 16 * ti + lr) * D + h * DV + vs * 64 + 16 * tv0 + 4 * lg;
            u32x2 w0, w1; w0.x = (unsigned)f2bf(a0[0]) | ((unsigned)f2bf(a0[1]) << 16); w0.y = (unsigned)f2bf(a0[2]) | ((unsigned)f2bf(a0[3]) << 16);
            w1.x = (unsigned)f2bf(a1[0]) | ((unsigned)f2bf(a1[1]) << 16); w1.y = (unsigned)f2bf(a1[2]) | ((unsigned)f2bf(a1[3]) << 16);
            *(u32x2*)op = w0; *(u32x2*)(op + 16) = w1; }
          { float s_ = ((a0[0] * a0[0] + a0[1] * a0[1]) + (a0[2] * a0[2] + a0[3] * a0[3])) + ((a1[0] * a1[0] + a1[1] * a1[1]) + (a1[2] * a1[2] + a1[3] * a1[3]));
            s_ += __shfl_xor(s_, 16); s_ += __shfl_xor(s_, 32);
            if (lg == 0) sq[(wave >> 2) * SEQ + n * CHUNK + 16 * ti + lr] = s_; } }
        { const int tv = wave & 3; bf16x8 vf[2];
#pragma unroll
          for (int ks = 0; ks < 2; ++ks) vf[ks] = *(const LAS bf16x8*)(Bc + C_VT + (16 * tv + lr) * S64 + (ks * 32 + 8 * lg) * 2);
#pragma unroll
          for (int c = 0; c < 4; ++c) { const int td = (wave >> 2) * 4 + c; const f32x4 dec4 = *(const LAS f32x4*)(Bc + C_DEC + (16 * td + 4 * lg) * 4);
            f32x4 a = stacc[c] * dec4;
#pragma unroll
            for (int ks = 0; ks < 2; ++ks) { const bf16x8 kf = *(const LAS bf16x8*)(Bc + C_KLT + (16 * td + lr) * S64 + (ks * 32 + 8 * lg) * 2);
                a = __builtin_amdgcn_mfma_f32_16x16x32_bf16(kf, vf[ks], a, 0, 0, 0); }
            stacc[c] = a; } }
        LDS_BARRIER();
        if (n + 1 < NCHUNK) { const int tv = wave & 3;
#pragma unroll
          for (int c = 0; c < 4; ++c) { const int td = (wave >> 2) * 4 + c; u32x2 w; w.x = (unsigned)f2bf(stacc[c][0]) | ((unsigned)f2bf(stacc[c][1]) << 16); w.y = (unsigned)f2bf(stacc[c][2]) | ((unsigned)f2bf(stacc[c][3]) << 16);
            *(LAS u32x2*)(Sc + (16 * tv + lr) * S128 + (16 * td + 4 * lg) * 2) = w; } }
        LDS_BARRIER();
    }
#undef CH_LOAD
#undef CH_STORE
#pragma unroll
    for (int j = 0; j < SEQ / NT; ++j) { const int t = tid + NT * j;
        const unsigned long long pr = (unsigned long long)__float_as_uint(sq[t]) | ((unsigned long long)__float_as_uint(sq[SEQ + t]) << 32);
        __hip_atomic_store((unsigned long long*)(SSQP + ((size_t)(h * 4 + vs) * M + tokb + t) * 2), pr, __ATOMIC_RELAXED, __HIP_MEMORY_SCOPE_AGENT); }
    asm volatile("s_waitcnt vmcnt(0)" ::: "memory");
    __syncthreads();
    if (tid == 0) {
        unsigned* c = cnt + (b * NH + h) * 64;
        (void)__hip_atomic_fetch_add(c, 1u, __ATOMIC_RELAXED, __HIP_MEMORY_SCOPE_AGENT);
        unsigned spins = 0;
        while (__hip_atomic_load(c, __ATOMIC_RELAXED, __HIP_MEMORY_SCOPE_AGENT) < 4u) { __builtin_amdgcn_s_sleep(2); if (++spins > (1u << 24)) break; }
    }
    __syncthreads();
    { LAS float* rt = (LAS float*)L;
#pragma unroll
      for (int j = 0; j < SEQ / NT; ++j) { const int t = tid + NT * j; float ssq = 0.f;
#pragma unroll
        for (int v4 = 0; v4 < 4; ++v4) { const float* sp = SSQP + ((size_t)(h * 4 + v4) * M + tokb + t) * 2;
            ssq += __hip_atomic_load(sp, __ATOMIC_RELAXED, __HIP_MEMORY_SCOPE_AGENT) + __hip_atomic_load(sp + 1, __ATOMIC_RELAXED, __HIP_MEMORY_SCOPE_AGENT); }
        rt[t] = 1.0f / sqrtf(ssq * (1.0f / DV) + EPS); }
      __syncthreads();
      const int c8 = (tid & 7) * 8, colh = vs * 64 + c8;
      const f32x4 g0 = *(const f32x4*)(gn_g + colh), g1 = *(const f32x4*)(gn_g + colh + 4);
      for (int pass0 = 0; pass0 < SEQ / 64; pass0 += 8) {
        u32x4 ov[8], sgv[8];
#pragma unroll
        for (int j = 0; j < 8; ++j) { const size_t off = (tokb + (pass0 + j) * 64 + (tid >> 3)) * D + h * DV + colh; ov[j] = __builtin_nontemporal_load((const u32x4*)(O + off)); sgv[j] = __builtin_nontemporal_load((const u32x4*)(SGR + off)); }
#pragma unroll
        for (int j = 0; j < 8; ++j) { const int t = (pass0 + j) * 64 + (tid >> 3); const size_t off = (tokb + t) * D + h * DV + colh;
            const float rstd = rt[t];
            const u32x4 o = ov[j], sg = sgv[j]; u32x4 w;
            const float q0 = bflo(sg.x), q1 = bfhi(sg.x), q2 = bflo(sg.y), q3 = bfhi(sg.y), q4 = bflo(sg.z), q5 = bfhi(sg.z), q6 = bflo(sg.w), q7 = bfhi(sg.w);
            w.x = pk2(bflo(o.x) * rstd * g0[0] * (q0 * sigm(q0)), bfhi(o.x) * rstd * g0[1] * (q1 * sigm(q1)));
            w.y = pk2(bflo(o.y) * rstd * g0[2] * (q2 * sigm(q2)), bfhi(o.y) * rstd * g0[3] * (q3 * sigm(q3)));
            w.z = pk2(bflo(o.z) * rstd * g1[0] * (q4 * sigm(q4)), bfhi(o.z) * rstd * g1[1] * (q5 * sigm(q5)));
            w.w = pk2(bflo(o.w) * rstd * g1[2] * (q6 * sigm(q6)), bfhi(o.w) * rstd * g1[3] * (q7 * sigm(q7)));
            __builtin_nontemporal_store(w, (u32x4*)(OG + off)); }
      }
      __syncthreads(); }
}

__device__ __forceinline__ void final_rows(const int lane, const int gw, const int NGW, const float* final_g, const float* ROWSS, float* out) {
    f32x4 g[4];
#pragma unroll
    for (int j = 0; j < 4; ++j) g[j] = *(const f32x4*)(final_g + 256 * j + 4 * lane);
    for (int m = gw; m < M; m += NGW) {
        float ssq = 0.f;
#pragma unroll
        for (int j = 0; j < 4; ++j) { const f32x4 p = *(const f32x4*)(ROWSS + ((size_t)j * M + m) * 4); ssq += (p[0] + p[1]) + (p[2] + p[3]); }
        const float rstd = 1.0f / sqrtf(ssq * (1.0f / D) + EPS);
        f32x4* xr = (f32x4*)(out + (size_t)m * D) + lane;
#pragma unroll
        for (int j = 0; j < 4; ++j) { const f32x4 v = xr[64 * j]; xr[64 * j] = v * rstd * g[j]; }
    }
}

__global__ void __launch_bounds__(NT, 2) fwd_megakernel(Args args) {
    extern __shared__ __attribute__((aligned(16))) unsigned char lds[];
    cg::grid_group grid = cg::this_grid();
#define GRID_SYNC() do { asm volatile("s_waitcnt vmcnt(0)" ::: "memory"); grid.sync(); asm volatile("buffer_inv sc1\n\ts_waitcnt vmcnt(0)" ::: "memory"); } while (0)
    LAS unsigned char* const L = (LAS unsigned char*)lds;
    const int tid = threadIdx.x, lane = tid & 63, wave = __builtin_amdgcn_readfirstlane(tid >> 6);
    const int G = gridDim.x; int bx = blockIdx.x, vcu = (G % 8 == 0) ? (bx % 8) * (G / 8) + bx / 8 : bx;
    int gw = vcu * NWAVES + wave; const int NGW = G * NWAVES;
    unsigned char* const ws = args.ws; unsigned char* const ob = (unsigned char*)args.out;
    if (tid < 4) ((LAS unsigned*)(L + LDS_MISC))[tid] = 0u;
    __syncthreads();
    const XcdBarrier xbar = xcd_barrier_post((unsigned*)(ws + WS_CTL), (volatile LAS unsigned*)(L + LDS_MISC));
#define XCD_SYNC() xcd_barrier(xbar)
#define P_WIN  ((bf16*)(ws + WS_WIN))
#define P_WCO  ((bf16*)(ws + WS_WCO))
#define P_WGO  ((bf16*)(ws + WS_WGO))
#define P_WO   ((bf16*)(ws + WS_WO))
#define P_GLR  ((float*)(ws + WS_GLR))
#define P_SSQP ((float*)(ws + WS_SSQP))
#define P_ROWSS ((float*)(ws + WS_ROWSS))
#ifndef P_H
#define P_H    ((bf16*)ob)
#endif
#define P_UC   ((bf16*)ob)
#define P_U    ((bf16*)(ob + 64 * MiB))
#define P_SZ   ((bf16*)(ws + WS_SZ))
#define P_YCM  ((bf16*)(ws + WS_Q))
#define P_Q    ((bf16*)(ws + WS_Q))
#define P_K    ((bf16*)(ws + WS_K))
#define P_Y    ((bf16*)(ws + WS_V))
#define P_V    ((bf16*)(ws + WS_V))
#define P_OG   ((bf16*)(ob + 64 * MiB))
#define P_SGR  ((bf16*)(ws + WS_SGR))
#define P_MC   ((bf16*)(ws + WS_MC))
#define P_MG   ((bf16*)(ws + WS_MG))
#define P_O    ((bf16*)(ws + WS_SZ))
#define P_PP   ((bf16*)(ws + WS_PP))
#define P_PQB  ((bf16*)(ws + WS_PQB))
#define P_PKLT ((bf16*)(ws + WS_PKLT))
#define P_PDEC ((float*)(ws + WS_PDEC))
#define P_CNT  ((unsigned*)(ws + WS_CNT))
#define P_CNT2 ((unsigned*)(ws + WS_CNT + 32768))

    const int lo = args.ph_lo, hi = args.ph_hi;
#define IN(k) (lo <= (k) && (k) < hi)
#define SEAM(k) do { if (IN(k) && IN((k) + 1)) { if (args.ph_hi > 1000) GRID_SYNC(); else XCD_SYNC(); } } while (0)
#ifndef REP_PHASE
#define REP_PHASE -1
#endif
#define REP(k) (REP_PHASE == (k) ? 2 : 1)
#define RUN_P0() do { \
    p0_prologue(L, tid, lane, wave, gw, NGW, args.in[0], args.in[1], args.in[2], args.in[7], args.in[11], args.in[12], P_WIN, P_WCO, P_WGO, P_WO, P_H, P_GLR); } while (0)
#define RUN_P1() do { pg8::Gemm g{P_H, P_WIN, M, NPROJ, D}; pg8::StaticOrder S; S.init(M, NPROJ, G, bx); EpiProj E{P_U, ws}; \
    pg8::gemm_phase<EpiProj, pg8::StaticOrder, PG8_ALIGN, PG8_SP2>(L, g, S, E); } while (0)
#define RUN_P2() do { \
    for (int t = vcu; t < M / 128; t += G) conv_tile(L, tid, lane, wave, t, args.in[3], args.in[4], args.in[5], args.in[6], P_U, P_SZ, P_UC); \
    {   \
      for (int v = vcu; v < BATCH * NH * 4; v += G) gla_prepass(L, tid, lane, wave, v >> 4, (v >> 2) & 3, (v & 3) * (NCHUNK / 4), NCHUNK / 4, args.in[8], args.in[9], P_Q, P_K, P_GLR, P_PP, P_PQB, P_PKLT, P_PDEC); } } while (0)
#define RUN_P3() do { \
    for (int c = vcu; c < BATCH * NH * 4; c += G) gla_chain(L, tid, lane, wave, c, P_V, P_PP, P_PQB, P_PKLT, P_PDEC, P_O, P_SSQP, P_CNT, args.in[10], P_SGR, P_OG); } while (0)
#define RUN_P4() do { pg8::Gemm g{P_UC, P_WCO, 2 * M, 2 * D, D}; BranchOrder S; S.init(G, bx); EpiBranches E{P_Y, P_YCM, P_MC, P_MG}; \
    pg8::gemm_phase<EpiBranches, BranchOrder, PG8_ALIGN, PG8_SP2>(L, g, S, E); } while (0)
#define RUN_P5() do { pg8::Gemm g{P_Y, P_WO, M, D, D}; EpiResNorm E{args.out, args.in[0], args.in[13], P_ROWSS, P_CNT2}; \
    _Pragma("unroll 1") for (int hf = 0; hf < 2; ++hf) { HalfOrder S; S.init(M / 2, D, G, bx); S.pmoff = hf * (M / 512); \
      pg8::gemm_phase<EpiResNorm, HalfOrder, false, PG8_SP2>(L, g, S, E); } } while (0)
#define RUN_P6() do { } while (0)

    if (IN(0)) RUN_P0();
#if REP_PHASE == 0
    XCD_SYNC(); RUN_P0();
#endif
    SEAM(0);
    if (IN(0) && IN(1)) {
        volatile LAS unsigned* ms = (volatile LAS unsigned*)(L + LDS_MISC);
        if (tid == 0) { unsigned* bar = (unsigned*)(ws + WS_CTL); unsigned pop = 0u, below = 0u; bool ok = (G % 8 == 0);
            for (unsigned j = 0; j < 16; ++j) { const unsigned cj = xb_ld(&bar[XB_XCNT(j)]); if (cj) { ++pop; if (j < xbar.x) ++below; if (cj != (unsigned)(G / 8)) ok = false; } }
            ok = ok && pop == 8u && ms[2] < (unsigned)(G / 8);
            ms[3] = ok ? (below + 8u * ms[2]) : (unsigned)blockIdx.x; }
        __syncthreads();
        bx = __builtin_amdgcn_readfirstlane((int)ms[3]); vcu = (G % 8 == 0) ? (bx % 8) * (G / 8) + bx / 8 : bx; gw = vcu * NWAVES + wave;
    }
    if (IN(1)) RUN_P1();
#if REP_PHASE == 1
    XCD_SYNC(); RUN_P1();
#endif
    SEAM(1);
    if (IN(2)) RUN_P2();
#if REP_PHASE == 2
    XCD_SYNC(); RUN_P2();
#endif
    SEAM(2);
    if (IN(3)) RUN_P3();
#if REP_PHASE == 3
    XCD_SYNC(); RUN_P3();
#endif
    SEAM(3);
    if (IN(4)) RUN_P4();
#if REP_PHASE == 4
    XCD_SYNC(); RUN_P4();
#endif
    SEAM(4);
    if (IN(5)) RUN_P5();
#if REP_PHASE == 5
    XCD_SYNC(); RUN_P5();
#endif
#ifdef DUMP_SRC
    if (IN(7)) { const bf16* src = DUMP_SRC;
#ifndef DUMP_ROWS
#define DUMP_ROWS M
#endif
        for (int m = gw; m < M; m += NGW) { u32x4 a = (u32x4){0u, 0u, 0u, 0u}, b = a; if (m < DUMP_ROWS) { a = *(const u32x4*)(src + (size_t)m * D + 8 * lane); b = *(const u32x4*)(src + (size_t)m * D + 512 + 8 * lane); }
            float* o = args.out + (size_t)m * D + 8 * lane;
            *(f32x4*)(o) = (f32x4){bflo(a.x), bfhi(a.x), bflo(a.y), bfhi(a.y)}; *(f32x4*)(o + 4) = (f32x4){bflo(a.z), bfhi(a.z), bflo(a.w), bfhi(a.w)};
            *(f32x4*)(o + 512) = (f32x4){bflo(b.x), bfhi(b.x), bflo(b.y), bfhi(b.y)}; *(f32x4*)(o + 516) = (f32x4){bflo(b.z), bfhi(b.z), bflo(b.w), bfhi(b.w)}; } }
#endif
}

extern "C" void kernel_launch(void* const* d_in, const int* in_sizes, int n_in, void* d_out, int out_size, void* d_ws, size_t ws_size, hipStream_t stream) {
    static int grid = 0;
    if (grid == 0) {
        if (n_in != 14 || in_sizes[0] != M * D || out_size != M * D || ws_size < WS_END) { fprintf(stderr, "kernel_launch: unexpected shapes (n_in %d, in0 %d, out %d, ws %zu)\n", n_in, n_in > 0 ? in_sizes[0] : -1, out_size, ws_size); grid = -1; return; }
        int dev = 0, cus = 0, per_cu = 0;
        if (hipGetDevice(&dev) != hipSuccess || hipDeviceGetAttribute(&cus, hipDeviceAttributeMultiprocessorCount, dev) != hipSuccess) { grid = -1; return; }
        if (hipFuncSetAttribute((const void*)fwd_megakernel, hipFuncAttributeMaxDynamicSharedMemorySize, LDS_BYTES) != hipSuccess) { fprintf(stderr, "kernel_launch: hipFuncSetAttribute failed\n"); grid = -1; return; }
        if (hipOccupancyMaxActiveBlocksPerMultiprocessor(&per_cu, (const void*)fwd_megakernel, NT, LDS_BYTES) != hipSuccess || per_cu < 1) { fprintf(stderr, "kernel_launch: occupancy query says %d\n", per_cu); per_cu = 1; }
        (void)hipGetLastError();
        grid = cus;
        if (grid != 256) fprintf(stderr, "kernel_launch: note: %d CUs (built for 256: the GLA chains expect one chain per workgroup)\n", grid);
    }
    if (grid < 0) return;
    if (hipMemsetAsync((char*)d_ws + WS_CTL, 0, CTL_ZERO_BYTES, stream) != hipSuccess) { fprintf(stderr, "kernel_launch: hipMemsetAsync failed\n"); return; }
    Args a{};
    for (int i = 0; i < 14; ++i) a.in[i] = (const float*)d_in[i];
    a.out = (float*)d_out; a.ws = (unsigned char*)d_ws;
    void* kargs[] = {&a};
    for (int li = 0; li < MK_N_LAUNCHES + MK_DUMP; ++li) {
#ifdef MK_LAST_PHASE
        if (li >= MK_LAST_PHASE && li < 7) continue;
#endif
        a.ph_lo = (MK_N_LAUNCHES == 1) ? 0 : li; a.ph_hi = (MK_N_LAUNCHES == 1) ? 6 : li + 1;
        const hipError_t e = hipLaunchCooperativeKernel((const void*)fwd_megakernel, dim3(grid), dim3(NT), kargs, LDS_BYTES, stream);
        if (e != hipSuccess) fprintf(stderr, "kernel_launch: cooperative launch failed: %s (grid %d)\n", hipGetErrorString(e), grid);
    }
}
```

```cpp
#include <hip/hip_runtime.h>
#include <hip/hip_cooperative_groups.h>
#include <cstdio>
#include <cstdint>
namespace cg = cooperative_groups;
namespace pg8 {
#define PG8_LAS __attribute__((address_space(3)))
typedef unsigned short bf16_t;
typedef short bf16x8 __attribute__((ext_vector_type(8)));
typedef float f32x4 __attribute__((ext_vector_type(4)));
typedef unsigned u32x4 __attribute__((ext_vector_type(4)));
constexpr int BM = 256, BK = 64, HALF = 128, HTB = HALF * BK * 2  , STAGE_BYTES = 8 * HTB, NXCD = 8, WGM = 4;

__host__ __device__ __forceinline__ int lds_byte(int r, int c) { const int st = (r >> 4) * 2 + (c >> 5), rr = r & 15, cc = c & 31, ob = rr * 64 + cc * 2; return st * 1024 + (ob ^ (((ob >> 9) & 1) << 5)); }
__host__ __device__ __forceinline__ void stage_rc(int b, int& R, int& C) { const int st = b / 1024, sb = b % 1024, swz = sb ^ (((sb >> 9) & 1) << 5); R = (st >> 1) * 16 + swz / 64; C = (st & 1) * 32 + (swz % 64) / 2; }
__host__ __device__ __forceinline__ int perm32(int rho) { const int n = rho >> 4, i = rho & 15; return 8 * (i >> 2) + 4 * n + (i & 3); }

struct Unit { int pm, pn; };
struct Gemm { const bf16_t* A; const bf16_t* Bt; int M, N, K; };

struct StaticOrder {
    int nM, nN, nwg, G, c;
    __host__ __device__ void init(int M, int N, int G_, int c_) { nM = M / BM; nN = N / BM; nwg = nM * nN; G = G_; c = c_; }
    __host__ __device__ bool next(int i, Unit& u) const {
        const long L = (long)i * G + c; if (L >= nwg) return false;
        int wgid = (int)L; { const int q = nwg / NXCD, r = nwg % NXCD, xcd = wgid % NXCD, off = wgid / NXCD; wgid = (xcd < r ? xcd * (q + 1) : r * (q + 1) + (xcd - r) * q) + off; }
        const int nig = WGM * nN, gid = wgid / nig, fm = gid * WGM, gsz = (nM - fm) < WGM ? (nM - fm) : WGM;
        u.pm = fm + ((wgid % nig) % gsz); u.pn = (wgid % nig) / gsz; return true;
    }
    __device__ __forceinline__ void a_ready(const Unit&) const {}
    __device__ __forceinline__ void done(const Unit&) const {}
};
__device__ __forceinline__ unsigned cvt_pk_bf16(float lo, float hi) { unsigned r; asm volatile("v_cvt_pk_bf16_f32 %0, %1, %2" : "=v"(r) : "v"(lo), "v"(hi)); return r; }
typedef float f32x2 __attribute__((ext_vector_type(2)));
template <class Epi, class Sched, bool ALIGN_EPI = false, bool SP2 = false>
__device__ __forceinline__ void gemm_phase(PG8_LAS unsigned char* lds, const Gemm g, const Sched& S, const Epi& E) {
    const int tid = threadIdx.x, wid = __builtin_amdgcn_readfirstlane(tid >> 6), lane = tid & 63, wr = wid >> 2, wc = wid & 3, fr = lane & 15, fq = lane >> 4;
    const int K = g.K, nt = K / BK;
    unsigned voffA[2], voffB[2];
#pragma unroll
    for (int i = 0; i < 2; ++i) { int R, C; stage_rc(tid * 16 + i * 8192, R, C); const int Rb = Epi::PERM ? ((R & ~31) + perm32(R & 31)) : R;
        voffA[i] = (unsigned)(R * K + C) * 2u; voffB[i] = (unsigned)(Rb * K + C) * 2u; }
    const size_t kstep = (size_t)(BK * 2);
    const size_t hstep = (size_t)HALF * K * 2;
    const size_t tstep = 2 * hstep;
    const unsigned ldsw = (unsigned)wid * 1024u;
    const int aoff = lds_byte(wr * 64 + fr, fq * 8), boff = lds_byte(wc * 32 + fr, fq * 8);
#define PG8_SA(b, h) (((b) * 2 + (h)) * HTB)
#define PG8_SB(b, h) ((4 + (b) * 2 + (h)) * HTB)
#define PG8_STAGE(bufoff, gbase, voff) do { _Pragma("unroll") for (int _i = 0; _i < 2; ++_i) \
        __builtin_amdgcn_global_load_lds((const unsigned*)((const char*)(gbase) + (voff)[_i]), (PG8_LAS unsigned*)(lds + (bufoff) + ldsw + _i * 8192), 16, 0, 0); } while (0)
#define PG8_LDA(dst, b, h) do { _Pragma("unroll") for (int m = 0; m < 4; ++m) _Pragma("unroll") for (int k = 0; k < 2; ++k) dst[m][k] = *(const PG8_LAS bf16x8*)(lds + PG8_SA(b, h) + aoff + m * 2048 + k * 1024); } while (0)
#define PG8_LDB(dst, b, h) do { _Pragma("unroll") for (int n = 0; n < 2; ++n) _Pragma("unroll") for (int k = 0; k < 2; ++k) dst[n][k] = *(const PG8_LAS bf16x8*)(lds + PG8_SB(b, h) + boff + n * 2048 + k * 1024); } while (0)
#define PG8_MMA(ai, bj, At, Bt) do { __builtin_amdgcn_s_setprio(1); _Pragma("unroll") for (int m = 0; m < 4; ++m) _Pragma("unroll") for (int n = 0; n < 2; ++n) _Pragma("unroll") for (int k = 0; k < 2; ++k) \
        acc[ai][bj][m][n] = __builtin_amdgcn_mfma_f32_16x16x32_bf16(Bt[n][k], At[m][k], acc[ai][bj][m][n], 0, 0, 0); __builtin_amdgcn_s_setprio(0); } while (0)
#define PG8_WAIT_V(n) asm volatile("s_waitcnt vmcnt(" #n ")" ::: "memory")
#define PG8_WAIT_L(n) asm volatile("s_waitcnt lgkmcnt(" #n ")" ::: "memory")
#define PG8_BAR __builtin_amdgcn_s_barrier()
#define PG8_SCHED __builtin_amdgcn_sched_barrier(0)
    Unit cur, nxt; int ui = 0;
    if (!S.next(0, cur)) return;
    f32x4 acc[2][2][4][2];
#pragma unroll
    for (int a = 0; a < 2; ++a)
#pragma unroll
        for (int b = 0; b < 2; ++b)
#pragma unroll
            for (int m = 0; m < 4; ++m)
#pragma unroll
                for (int n = 0; n < 2; ++n) acc[a][b][m][n] = (f32x4){0.f, 0.f, 0.f, 0.f};
    bf16x8 At[4][2], B0[2][2], B1[2][2];
    const char* cA = (const char*)g.A + (size_t)cur.pm * tstep; const char* cB = (const char*)g.Bt + (size_t)cur.pn * tstep;
    S.a_ready(cur);
    if constexpr (SP2) {
        PG8_STAGE(PG8_SB(0, 0), cB, voffB); PG8_STAGE(PG8_SB(0, 1), cB + hstep, voffB); PG8_STAGE(PG8_SA(0, 0), cA, voffA); PG8_STAGE(PG8_SA(0, 1), cA + hstep, voffA);
        if (wr == 1) PG8_BAR;
        PG8_WAIT_V(2); PG8_BAR;
        PG8_STAGE(PG8_SB(1, 0), cB + kstep, voffB); PG8_STAGE(PG8_SA(1, 0), cA + kstep, voffA); PG8_STAGE(PG8_SB(1, 1), cB + hstep + kstep, voffB);
        PG8_WAIT_V(6); PG8_BAR;
    } else {
        PG8_STAGE(PG8_SB(0, 0), cB, voffB); PG8_STAGE(PG8_SA(0, 0), cA, voffA); PG8_STAGE(PG8_SB(0, 1), cB + hstep, voffB); PG8_STAGE(PG8_SA(0, 1), cA + hstep, voffA);
        if (wr == 1) PG8_BAR;
        PG8_WAIT_V(4); PG8_BAR;
        PG8_STAGE(PG8_SB(1, 0), cB + kstep, voffB); PG8_STAGE(PG8_SA(1, 0), cA + kstep, voffA); PG8_STAGE(PG8_SB(1, 1), cB + hstep + kstep, voffB);
        PG8_WAIT_V(6); PG8_BAR;
    }
    for (;;) {
        const bool has_next = S.next(ui + 1, nxt);
        const char* nA = has_next ? (const char*)g.A + (size_t)nxt.pm * tstep : cA; const char* nB = has_next ? (const char*)g.Bt + (size_t)nxt.pn * tstep : cB;
        for (int t = 0; t < nt; t += 2) {
            const bool last = (t == nt - 2);
            const char* a1 = cA + (size_t)(t + 1) * kstep;
            const char* a2 = last ? nA : cA + (size_t)(t + 2) * kstep; const char* b2 = last ? nB : cB + (size_t)(t + 2) * kstep;
            const char* a3 = a2 + kstep; const char* b3 = b2 + kstep;
            if (last && has_next) S.a_ready(nxt);
            if constexpr (SP2) {
            PG8_LDB(B0, 0, 0); PG8_LDB(B1, 0, 1); PG8_SCHED; PG8_LDA(At, 0, 0); PG8_STAGE(PG8_SA(1, 1), a1 + hstep, voffA);
            PG8_WAIT_V(8); PG8_WAIT_L(0); PG8_BAR; PG8_MMA(0, 0, At, B0); PG8_MMA(0, 1, At, B1); PG8_BAR; PG8_SCHED;
            PG8_LDA(At, 0, 1); PG8_STAGE(PG8_SB(0, 0), b2, voffB); PG8_STAGE(PG8_SB(0, 1), b2 + hstep, voffB); PG8_STAGE(PG8_SA(0, 0), a2, voffA);
            PG8_WAIT_V(8); PG8_WAIT_L(0); PG8_BAR; PG8_MMA(1, 0, At, B0); PG8_MMA(1, 1, At, B1); PG8_BAR; PG8_SCHED;
            PG8_LDB(B0, 1, 0); PG8_LDB(B1, 1, 1); PG8_SCHED; PG8_LDA(At, 1, 0); PG8_STAGE(PG8_SA(0, 1), a2 + hstep, voffA);
            PG8_WAIT_V(8); PG8_WAIT_L(0); PG8_BAR; PG8_MMA(0, 0, At, B0); PG8_MMA(0, 1, At, B1); PG8_BAR; PG8_SCHED;
            PG8_LDA(At, 1, 1); PG8_STAGE(PG8_SB(1, 0), b3, voffB); PG8_STAGE(PG8_SB(1, 1), b3 + hstep, voffB); PG8_STAGE(PG8_SA(1, 0), a3, voffA);
            PG8_WAIT_V(8); PG8_WAIT_L(0); PG8_BAR; PG8_MMA(1, 0, At, B0); PG8_MMA(1, 1, At, B1); PG8_BAR; PG8_SCHED;
            } else {
            PG8_LDB(B0, 0, 0); PG8_SCHED; PG8_LDA(At, 0, 0); PG8_STAGE(PG8_SA(1, 1), a1 + hstep, voffA);
            PG8_WAIT_L(8); PG8_BAR; PG8_WAIT_L(0); PG8_MMA(0, 0, At, B0); PG8_BAR; PG8_SCHED;
            PG8_LDB(B1, 0, 1); PG8_STAGE(PG8_SB(0, 0), b2, voffB);
            PG8_BAR; PG8_WAIT_L(0); PG8_MMA(0, 1, At, B1); PG8_BAR;
            PG8_LDA(At, 0, 1); PG8_STAGE(PG8_SA(0, 0), a2, voffA);
            PG8_BAR; PG8_WAIT_L(0); PG8_MMA(1, 0, At, B0); PG8_BAR; PG8_SCHED;
            PG8_STAGE(PG8_SB(0, 1), b2 + hstep, voffB);
            PG8_WAIT_V(6); PG8_BAR; PG8_MMA(1, 1, At, B1); PG8_BAR;
            PG8_LDB(B0, 1, 0); PG8_SCHED; PG8_LDA(At, 1, 0); PG8_STAGE(PG8_SA(0, 1), a2 + hstep, voffA);
            PG8_WAIT_L(8); PG8_BAR; PG8_WAIT_L(0); PG8_MMA(0, 0, At, B0); PG8_BAR; PG8_SCHED;
            PG8_LDB(B1, 1, 1); PG8_STAGE(PG8_SB(1, 0), b3, voffB);
            PG8_BAR; PG8_WAIT_L(0); PG8_MMA(0, 1, At, B1); PG8_BAR;
            PG8_LDA(At, 1, 1); PG8_STAGE(PG8_SA(1, 0), a3, voffA);
            PG8_BAR; PG8_WAIT_L(0); PG8_MMA(1, 0, At, B0); PG8_BAR; PG8_SCHED;
            PG8_STAGE(PG8_SB(1, 1), b3 + hstep, voffB);
            PG8_WAIT_V(6); PG8_BAR; PG8_MMA(1, 1, At, B1); PG8_BAR;
            }
        }
        if constexpr (ALIGN_EPI) { if (wr == 0) PG8_BAR; }
        if constexpr (!Epi::AFTER_DRAIN) { E(acc, cur, wr, wc, fr, fq); S.done(cur); }
        if (!has_next) break;
#pragma unroll
        for (int a = 0; a < 2; ++a)
#pragma unroll
            for (int b = 0; b < 2; ++b)
#pragma unroll
                for (int m = 0; m < 4; ++m)
#pragma unroll
                    for (int n = 0; n < 2; ++n) acc[a][b][m][n] = (f32x4){0.f, 0.f, 0.f, 0.f};
        cur = nxt; cA = nA; cB = nB; ++ui;
        if constexpr (ALIGN_EPI) { if (wr == 1) PG8_BAR; }
    }
    PG8_WAIT_V(0);
    if constexpr (!ALIGN_EPI) { if (wr == 0) PG8_BAR; }
    PG8_BAR;
    if constexpr (Epi::AFTER_DRAIN) { E.fused(acc, cur, wr, wc, fr, fq, lds, wid, lane); S.done(cur); }
#undef PG8_SA
#undef PG8_SB
#undef PG8_STAGE
#undef PG8_LDA
#undef PG8_LDB
#undef PG8_MMA
#undef PG8_WAIT_V
#undef PG8_WAIT_L
#undef PG8_BAR
#undef PG8_SCHED
}
}

#ifndef MK_N_LAUNCHES
#define MK_N_LAUNCHES 1
#endif
#ifdef DUMP_SRC
#define MK_DUMP 1
#else
#define MK_DUMP 0
#endif
#ifndef PG8_SP2
#define PG8_SP2 true
#endif
#ifndef PG8_ALIGN
#define PG8_ALIGN true
#endif

constexpr int D = 1024, BATCH = 16, SEQ = 2048, M = BATCH * SEQ;
constexpr int INW = 8208, NPROJ = 8192;
constexpr int CONVK = 31, NH = 4, DK = 128, DV = 256, KD = 512, RANK = 16, CHUNK = 64, NCHUNK = SEQ / CHUNK;
constexpr float EPS = 1e-6f;
constexpr int NWAVES = 8, NT = NWAVES * 64;

constexpr size_t MiB = 1u << 20;
constexpr size_t WS_WIN = 1 * MiB, WS_WCO = 17 * MiB, WS_WGO = 19 * MiB, WS_WO = 21 * MiB;
constexpr size_t WS_GLR = 23 * MiB;
constexpr size_t WS_SSQP = 25 * MiB;
constexpr size_t WS_ROWSS = 29 * MiB;
constexpr size_t WS_CTL = 0, CTL_ZERO_BYTES = 131072;
constexpr size_t WS_CNT = 65536;
constexpr size_t WS_SZ = 32 * MiB;
constexpr size_t WS_Q = 96 * MiB;
constexpr size_t WS_K = 128 * MiB;
constexpr size_t WS_V = 160 * MiB;
constexpr size_t WS_SGR = 224 * MiB;
constexpr size_t WS_MC = 288 * MiB;
constexpr size_t WS_MG = 352 * MiB;
constexpr size_t WS_PP = 416 * MiB, WS_PQB = 432 * MiB, WS_PKLT = 464 * MiB, WS_PDEC = 496 * MiB;
constexpr size_t WS_END = 497 * MiB;

constexpr int LDS_BYTES = 147456;
constexpr int LDS_MISC = 147200;

#define LAS __attribute__((address_space(3)))
typedef unsigned short bf16;
typedef float f32x4 __attribute__((ext_vector_type(4)));
typedef float f32x2 __attribute__((ext_vector_type(2)));
typedef short bf16x8 __attribute__((ext_vector_type(8)));
typedef unsigned u32x4 __attribute__((ext_vector_type(4)));
typedef unsigned u32x2 __attribute__((ext_vector_type(2)));

__device__ __forceinline__ float bf2f(unsigned b) { return __uint_as_float(b << 16); }
__device__ __forceinline__ float bflo(unsigned w) { return __uint_as_float(w << 16); }
__device__ __forceinline__ float bfhi(unsigned w) { return __uint_as_float(w & 0xffff0000u); }
typedef __bf16 bf16v2 __attribute__((ext_vector_type(2)));
__device__ __forceinline__ unsigned pk2(float lo, float hi) { return pg8::cvt_pk_bf16(lo, hi); }
__device__ __forceinline__ unsigned short f2bf(float f) { return __builtin_bit_cast(unsigned short, (__bf16)f); }
__device__ __forceinline__ float sigm(float x) { return __builtin_amdgcn_rcpf(1.0f + __expf(-x)); }
#define LDS_BARRIER() do { asm volatile("s_waitcnt lgkmcnt(0)" ::: "memory"); __builtin_amdgcn_s_barrier(); asm volatile("" ::: "memory"); } while (0)
__device__ __forceinline__ float wave_sum(float v) {
#pragma unroll
    for (int o = 1; o < 64; o <<= 1) v += __shfl_xor(v, o);
    return v;
}
__device__ __forceinline__ float reduce16(const float (&v)[16], int lane) {
    float a[8], b[4], c[2], d;
    const bool h5 = lane & 32, h4 = lane & 16, h3 = lane & 8, h2 = lane & 4;
#pragma unroll
    for (int i = 0; i < 8; ++i) { const float mine = h5 ? v[8 + i] : v[i], theirs = h5 ? v[i] : v[8 + i]; a[i] = mine + __shfl_xor(theirs, 32); }
#pragma unroll
    for (int i = 0; i < 4; ++i) { const float mine = h4 ? a[4 + i] : a[i], theirs = h4 ? a[i] : a[4 + i]; b[i] = mine + __shfl_xor(theirs, 16); }
#pragma unroll
    for (int i = 0; i < 2; ++i) { const float mine = h3 ? b[2 + i] : b[i], theirs = h3 ? b[i] : b[2 + i]; c[i] = mine + __shfl_xor(theirs, 8); }
    { const float mine = h2 ? c[1] : c[0], theirs = h2 ? c[0] : c[1]; d = mine + __shfl_xor(theirs, 4); }
    d += __shfl_xor(d, 2); d += __shfl_xor(d, 1);
    return d;
}

__device__ __forceinline__ float reduce8(const float (&v)[8], int lane) {
    float a[4], b[2], c;
    const bool h5 = lane & 32, h4 = lane & 16, h3 = lane & 8;
#pragma unroll
    for (int i = 0; i < 4; ++i) { const float mine = h5 ? v[4 + i] : v[i], theirs = h5 ? v[i] : v[4 + i]; a[i] = mine + __shfl_xor(theirs, 32); }
#pragma unroll
    for (int i = 0; i < 2; ++i) { const float mine = h4 ? a[2 + i] : a[i], theirs = h4 ? a[i] : a[2 + i]; b[i] = mine + __shfl_xor(theirs, 16); }
    { const float mine = h3 ? b[1] : b[0], theirs = h3 ? b[0] : b[1]; c = mine + __shfl_xor(theirs, 8); }
    c += __shfl_xor(c, 4); c += __shfl_xor(c, 2); c += __shfl_xor(c, 1);
    return c;
}

struct EpiProj {
    static constexpr bool PERM = true, AFTER_DRAIN = false;
    bf16* U; unsigned char* ws;
    __device__ __forceinline__ void operator()(const f32x4 (&acc)[2][2][4][2], const pg8::Unit& u, int wr, int wc, int fr, int fq) const {
        const int row0 = u.pm * 256 + wr * 64 + fr, pn = u.pn, cw = wc * 32 + 8 * fq;
        if (pn < 8) {
            bf16* base = U + (size_t)row0 * 1024 + pn * 128 + cw;
#pragma unroll
            for (int ai = 0; ai < 2; ++ai)
#pragma unroll
                for (int m = 0; m < 4; ++m) {
                    f32x4 a0 = acc[ai][0][m][0], a1 = acc[ai][0][m][1]; const f32x4 g0 = acc[ai][1][m][0], g1 = acc[ai][1][m][1];
#pragma unroll
                    for (int e = 0; e < 4; ++e) { a0[e] *= sigm(g0[e]); a1[e] *= sigm(g1[e]); }
                    u32x4 w; w.x = pk2(a0[0], a0[1]); w.y = pk2(a0[2], a0[3]); w.z = pk2(a1[0], a1[1]); w.w = pk2(a1[2], a1[3]);
                    __builtin_nontemporal_store(w, (u32x4*)(base + (size_t)(ai * 128 + m * 16) * 1024)); }
        } else {
            size_t boff; int ld, colt, mode; float sc = 1.f;
            if (pn < 12)      { boff = WS_SZ;  ld = 1024; colt = (pn - 8) * 256;  mode = 0; }
            else if (pn < 14) { boff = WS_Q;   ld = 512;  colt = (pn - 12) * 256; mode = 0; sc = 0.08838834764831845f; }
            else if (pn < 16) { boff = WS_K;   ld = 512;  colt = (pn - 14) * 256; mode = 0; }
            else if (pn < 20) { boff = WS_V;   ld = 1024; colt = (pn - 16) * 256; mode = 0; }
            else if (pn < 24) { boff = WS_SGR; ld = 1024; colt = (pn - 20) * 256; mode = 0; }
            else if (pn < 28) { boff = WS_MC;  ld = 1024; colt = (pn - 24) * 256; mode = 2; }
            else              { boff = WS_MG;  ld = 1024; colt = (pn - 28) * 256; mode = 2; }
            bf16* base = (bf16*)(ws + boff);
            base += (size_t)row0 * ld + colt + cw;
#pragma unroll
            for (int ai = 0; ai < 2; ++ai)
#pragma unroll
                for (int m = 0; m < 4; ++m)
#pragma unroll
                    for (int bj = 0; bj < 2; ++bj) {
                        f32x4 v0 = acc[ai][bj][m][0], v1 = acc[ai][bj][m][1];
                        if (mode == 0) { v0 = v0 * sc; v1 = v1 * sc; }
                        else {
#pragma unroll
                            for (int e = 0; e < 4; ++e) { const float s0 = sigm(v0[e]), s1 = sigm(v1[e]); v0[e] = (mode == 1) ? v0[e] * s0 : s0; v1[e] = (mode == 1) ? v1[e] * s1 : s1; }
                        }
                        u32x4 w; w.x = pk2(v0[0], v0[1]); w.y = pk2(v0[2], v0[3]); w.z = pk2(v1[0], v1[1]); w.w = pk2(v1[2], v1[3]);
                        __builtin_nontemporal_store(w, (u32x4*)(base + (size_t)(ai * 128 + m * 16) * ld + bj * 128)); }
        }
    }
};
struct EpiMul {
    static constexpr bool PERM = true, AFTER_DRAIN = false;
    bf16* O; const bf16* G;
    __device__ __forceinline__ void operator()(const f32x4 (&acc)[2][2][4][2], const pg8::Unit& u, int wr, int wc, int fr, int fq) const {
        const size_t off0 = (size_t)(u.pm * 256 + wr * 64 + fr) * 1024 + u.pn * 256 + wc * 32 + 8 * fq;
#pragma unroll
        for (int ai = 0; ai < 2; ++ai) {
            u32x4 gv[4][2];
#pragma unroll
            for (int m = 0; m < 4; ++m)
#pragma unroll
                for (int bj = 0; bj < 2; ++bj) gv[m][bj] = __builtin_nontemporal_load((const u32x4*)(G + off0 + (size_t)(ai * 128 + m * 16) * 1024 + bj * 128));
#pragma unroll
            for (int m = 0; m < 4; ++m)
#pragma unroll
                for (int bj = 0; bj < 2; ++bj) {
                    const size_t off = off0 + (size_t)(ai * 128 + m * 16) * 1024 + bj * 128;
                    const u32x4 g = gv[m][bj]; const f32x4 v0 = acc[ai][bj][m][0], v1 = acc[ai][bj][m][1];
                    u32x4 w; w.x = pk2(v0[0] * bflo(g.x), v0[1] * bfhi(g.x)); w.y = pk2(v0[2] * bflo(g.y), v0[3] * bfhi(g.y));
                    w.z = pk2(v1[0] * bflo(g.z), v1[1] * bfhi(g.z)); w.w = pk2(v1[2] * bflo(g.w), v1[3] * bfhi(g.w));
                    *(u32x4*)(O + off) = w; }
        }
    }
};
struct EpiMerge {
    static constexpr bool PERM = true, AFTER_DRAIN = false;
    bf16* O; const bf16* C; const bf16* G;
    __device__ __forceinline__ void operator()(const f32x4 (&acc)[2][2][4][2], const pg8::Unit& u, int wr, int wc, int fr, int fq) const {
        const size_t off0 = (size_t)(u.pm * 256 + wr * 64 + fr) * 1024 + u.pn * 256 + wc * 32 + 8 * fq;
#pragma unroll
        for (int ai = 0; ai < 2; ++ai) {
            u32x4 gv[4][2], cv[4][2];
#pragma unroll
            for (int m = 0; m < 4; ++m)
#pragma unroll
                for (int bj = 0; bj < 2; ++bj) { const size_t off = off0 + (size_t)(ai * 128 + m * 16) * 1024 + bj * 128; gv[m][bj] = __builtin_nontemporal_load((const u32x4*)(G + off)); cv[m][bj] = __builtin_nontemporal_load((const u32x4*)(C + off)); }
#pragma unroll
            for (int m = 0; m < 4; ++m)
#pragma unroll
                for (int bj = 0; bj < 2; ++bj) {
                    const size_t off = off0 + (size_t)(ai * 128 + m * 16) * 1024 + bj * 128;
                    const u32x4 g = gv[m][bj], c = cv[m][bj]; const f32x4 v0 = acc[ai][bj][m][0], v1 = acc[ai][bj][m][1];
                    u32x4 w; w.x = pk2(bflo(c.x) + v0[0] * bflo(g.x), bfhi(c.x) + v0[1] * bfhi(g.x)); w.y = pk2(bflo(c.y) + v0[2] * bflo(g.y), bfhi(c.y) + v0[3] * bfhi(g.y));
                    w.z = pk2(bflo(c.z) + v1[0] * bflo(g.z), bfhi(c.z) + v1[1] * bfhi(g.z)); w.w = pk2(bflo(c.w) + v1[2] * bflo(g.w), bfhi(c.w) + v1[3] * bfhi(g.w));
                    *(u32x4*)(O + off) = w; }
        }
    }
};
struct EpiRes {
    static constexpr bool PERM = false, AFTER_DRAIN = false;
    float* out; const float* X; float* SS;
    __device__ __forceinline__ void operator()(const f32x4 (&acc)[2][2][4][2], const pg8::Unit& u, int wr, int wc, int fr, int fq) const {
        const int row0 = u.pm * 256 + wr * 64 + fr, col0 = u.pn * 256 + wc * 32 + 4 * fq;
#pragma unroll
        for (int ai = 0; ai < 2; ++ai)
#pragma unroll
            for (int m = 0; m < 4; ++m) {
                const int row = row0 + ai * 128 + m * 16; const size_t off = (size_t)row * 1024 + col0; float s = 0.f;
#pragma unroll
                for (int bj = 0; bj < 2; ++bj)
#pragma unroll
                    for (int n = 0; n < 2; ++n) { const f32x4 r = *(const f32x4*)(X + off + bj * 128 + n * 16) + acc[ai][bj][m][n]; *(f32x4*)(out + off + bj * 128 + n * 16) = r;
                        s += (r[0] * r[0] + r[1] * r[1]) + (r[2] * r[2] + r[3] * r[3]); }
                s += __shfl_xor(s, 16); s += __shfl_xor(s, 32);
                if (fq == 0) SS[((size_t)u.pn * M + row) * 4 + wc] = s; }
    }
};

struct EpiBranches {
    static constexpr bool PERM = true, AFTER_DRAIN = false;
    bf16* Y; bf16* YCM; const bf16* MC; const bf16* MG;
    __device__ __forceinline__ void operator()(const f32x4 (&acc)[2][2][4][2], const pg8::Unit& u, int wr, int wc, int fr, int fq) const {
        if (u.pn < 4) { EpiMul e{YCM, MC}; e(acc, u, wr, wc, fr, fq); }
        else { pg8::Unit v; v.pm = u.pm - M / 256; v.pn = u.pn - 4; EpiMerge e{Y, YCM, MG}; e(acc, v, wr, wc, fr, fq); }
    }
};
struct BranchOrder {
    pg8::StaticOrder base; int nb;
    __device__ __forceinline__ void init(int G, int c) { base.init(M, D, G, c); nb = (base.nwg - c + G - 1) / G; }
    __device__ __forceinline__ bool next(int i, pg8::Unit& u) const { const int s = (i >= nb) ? 1 : 0, j = i - s * nb; if (j >= nb) return false; const bool ok = base.next(j, u); u.pm += s * (M / 256); u.pn += s * 4; return ok; }
    __device__ __forceinline__ void a_ready(const pg8::Unit&) const {}
    __device__ __forceinline__ void done(const pg8::Unit&) const {}
};

struct EpiResNorm {
    static constexpr bool PERM = false, AFTER_DRAIN = true;
    float* out; const float* X; const float* Gn; float* slots; unsigned* cnt;
    __device__ __forceinline__ void fused(f32x4 (&acc)[2][2][4][2], const pg8::Unit& u, int wr, int wc, int fr, int fq, PG8_LAS unsigned char* lds, int wid, int lane) const {
        PG8_LAS float* Pt = (PG8_LAS float*)lds;
        PG8_LAS float* St = (PG8_LAS float*)(lds + 4096);
        const int tid = wid * 64 + lane, col0 = u.pn * 256 + wc * 32 + 4 * fq;
#pragma unroll
        for (int ai = 0; ai < 2; ++ai)
#pragma unroll
            for (int m = 0; m < 4; ++m) {
                const int rl = ai * 128 + wr * 64 + m * 16 + fr; const size_t off = (size_t)(u.pm * 256 + rl) * 1024 + col0; float s = 0.f;
#pragma unroll
                for (int bj = 0; bj < 2; ++bj)
#pragma unroll
                    for (int n = 0; n < 2; ++n) { const f32x4 r = __builtin_nontemporal_load((const f32x4*)(X + off + bj * 128 + n * 16)) + acc[ai][bj][m][n]; acc[ai][bj][m][n] = r;
                        s += (r[0] * r[0] + r[1] * r[1]) + (r[2] * r[2] + r[3] * r[3]); }
                s += __shfl_xor(s, 16); s += __shfl_xor(s, 32);
                if (fq == 0) Pt[rl * 4 + wc] = s; }
        __syncthreads();
        if (tid < 256) { const f32x4 p = *(const PG8_LAS f32x4*)(Pt + tid * 4); __hip_atomic_store(slots + ((size_t)u.pm * 4 + u.pn) * 256 + tid, (p[0] + p[1]) + (p[2] + p[3]), __ATOMIC_RELAXED, __HIP_MEMORY_SCOPE_AGENT); }
        asm volatile("s_waitcnt vmcnt(0)" ::: "memory");
        __syncthreads();
        if (tid == 0) {
            unsigned* c = cnt + u.pm * 64;
            (void)__hip_atomic_fetch_add(c, 1u, __ATOMIC_RELAXED, __HIP_MEMORY_SCOPE_AGENT);
            unsigned spins = 0;
            while (__hip_atomic_load(c, __ATOMIC_RELAXED, __HIP_MEMORY_SCOPE_AGENT) < 4u) { __builtin_amdgcn_s_sleep(1); if (++spins > (1u << 24)) break; }
        }
        __syncthreads();
        if (tid < 256) { float ssq = 0.f;
#pragma unroll
            for (int q = 0; q < 4; ++q) ssq += __hip_atomic_load(slots + ((size_t)u.pm * 4 + q) * 256 + tid, __ATOMIC_RELAXED, __HIP_MEMORY_SCOPE_AGENT);
            St[tid] = 1.0f / sqrtf(ssq * (1.0f / 1024.0f) + 1e-6f); }
        __syncthreads();
#pragma unroll
        for (int ai = 0; ai < 2; ++ai)
#pragma unroll
            for (int m = 0; m < 4; ++m) {
                const int rl = ai * 128 + wr * 64 + m * 16 + fr; const size_t off = (size_t)(u.pm * 256 + rl) * 1024 + col0; const float rstd = St[rl];
#pragma unroll
                for (int bj = 0; bj < 2; ++bj)
#pragma unroll
                    for (int n = 0; n < 2; ++n) { const f32x4 g4 = *(const f32x4*)(Gn + col0 + bj * 128 + n * 16); __builtin_nontemporal_store(acc[ai][bj][m][n] * rstd * g4, (f32x4*)(out + off + bj * 128 + n * 16)); } }
        __syncthreads();
    }
};
struct HalfOrder : pg8::StaticOrder {
    int pmoff;
    __device__ __forceinline__ bool next(int i, pg8::Unit& u) const { const bool ok = pg8::StaticOrder::next(i, u); u.pm += pmoff; return ok; }
};

struct Args { const float* in[14]; float* out; unsigned char* ws; int ph_lo, ph_hi; };

__device__ __forceinline__ int srcmap(int n) {
    if (n < 2048) { const int pn = n >> 8, i = n & 255; return (i < 128) ? (128 * pn + i) : (1024 + 128 * pn + (i - 128)); }
    return (n < 5120) ? n : n + 16;
}
__device__ __forceinline__ void transpose_item(const float* W, int ldw, int src0, bf16* WT, int K, int dst0, int k0, LAS float* scr, int lane) {
#pragma unroll 8
    for (int i = 0; i < 32; ++i) { const int kk = 2 * i + (lane >> 5); scr[kk * 33 + (lane & 31)] = __builtin_nontemporal_load(W + (size_t)(k0 + kk) * ldw + src0 + (lane & 31)); }
    asm volatile("s_waitcnt lgkmcnt(0)" ::: "memory");
    const int c = lane & 7;
#pragma unroll
    for (int j = 0; j < 4; ++j) { const int n = (lane >> 3) + 8 * j; const LAS float* s = scr + (8 * c) * 33 + n;
        u32x4 o; o.x = pk2(s[0 * 33], s[1 * 33]); o.y = pk2(s[2 * 33], s[3 * 33]); o.z = pk2(s[4 * 33], s[5 * 33]); o.w = pk2(s[6 * 33], s[7 * 33]);
        *(u32x4*)(WT + (size_t)(dst0 + n) * K + k0 + 8 * c) = o; }
    asm volatile("s_waitcnt lgkmcnt(0)" ::: "memory");
}

#define XB_TMO      128
#define XB_XCNT(j)  (256  + 64 * (j))
#define XB_XSUB(j)  (1280 + 64 * (j))
#define XB_XGEN(j)  (2304 + 64 * (j))
#define XB_TOP      3328
#define XB_TOPGEN   3392
#define XCD_BAR_WORDS 3456
#define XB_SPIN_CAP (1u << 18)

__device__ __forceinline__ unsigned xb_ld(unsigned* p)              { return __hip_atomic_load(p, __ATOMIC_RELAXED, __HIP_MEMORY_SCOPE_AGENT); }
__device__ __forceinline__ unsigned xb_add(unsigned* p, unsigned v) { return __hip_atomic_fetch_add(p, v, __ATOMIC_RELAXED, __HIP_MEMORY_SCOPE_AGENT); }
__device__ __forceinline__ unsigned xb_xcc_id() { return (unsigned)__builtin_amdgcn_s_getreg((3 << 11) | 20) & 0xFu; }
#define XB_SPIN(cond, bar) do { unsigned _sp = 0; while (cond) { __builtin_amdgcn_s_sleep(1); \
    if ((++_sp & 255u) == 0u) { if (xb_ld(&(bar)[XB_TMO])) break; if (_sp > XB_SPIN_CAP) { atomicAdd(&(bar)[XB_TMO], 1u); break; } } } } while (0)

struct XcdBarrier {
    unsigned* bar; unsigned x;
    volatile LAS unsigned* st;
};

__device__ __forceinline__ XcdBarrier xcd_barrier_post(unsigned* bar, volatile LAS unsigned* st) {
    XcdBarrier b; b.bar = bar; b.x = xb_xcc_id(); b.st = st;
    if (threadIdx.x == 0) st[2] = xb_add(&bar[XB_XCNT(b.x)], 1u);
    return b;
}
__device__ __forceinline__ void xcd_barrier_complete(unsigned* bar, unsigned x, unsigned& nloc, unsigned& nx) {
    const unsigned G = gridDim.x * gridDim.y * gridDim.z;
    unsigned sum, cnt, mine, sp = 0u;
    for (;;) {
        sum = 0u; cnt = 0u; mine = 0u;
#pragma unroll
        for (unsigned j = 0; j < 16; ++j) { const unsigned c = xb_ld(&bar[XB_XCNT(j)]); sum += c; cnt += (c > 0u) ? 1u : 0u; mine = (j == x) ? c : mine; }
        if (sum == G) break;
        __builtin_amdgcn_s_sleep(1);
        if ((++sp & 255u) == 0u) { if (xb_ld(&bar[XB_TMO])) break; if (sp > XB_SPIN_CAP) { atomicAdd(&bar[XB_TMO], 1u); break; } }
    }
    nloc = mine > 0u ? mine : 1u; nx = cnt > 0u ? cnt : 1u;
}

__device__ __forceinline__ void xcd_barrier(const XcdBarrier& b) {
    asm volatile("s_waitcnt vmcnt(0)" ::: "memory");
    __syncthreads();
    if (threadIdx.x == 0) {
        unsigned* bar = b.bar;
        __builtin_amdgcn_s_waitcnt(0);
        unsigned nloc = b.st[0], nx = b.st[1];
        if (nloc == 0u) { xcd_barrier_complete(bar, b.x, nloc, nx); b.st[0] = nloc; b.st[1] = nx; }
        const unsigned old = xb_add(&bar[XB_XSUB(b.x)], 1u);
        const unsigned gen = old / nloc;
        if (old + 1u == (gen + 1u) * nloc) {
            __builtin_amdgcn_fence(__ATOMIC_RELEASE, "agent");
            asm volatile("s_waitcnt vmcnt(0)" ::: "memory");
            const unsigned og = xb_add(&bar[XB_TOP], 1u);
            const unsigned tg = og / nx;
            if (og + 1u == (tg + 1u) * nx) xb_add(&bar[XB_TOPGEN], 1u);
            else XB_SPIN(xb_ld(&bar[XB_TOPGEN]) == tg, bar);
            __builtin_amdgcn_fence(__ATOMIC_ACQUIRE, "agent");
            xb_add(&bar[XB_XGEN(b.x)], 1u);
            asm volatile("s_waitcnt vmcnt(0)" ::: "memory");
        } else {
            XB_SPIN(xb_ld(&bar[XB_XGEN(b.x)]) == gen, bar);
            __builtin_amdgcn_fence(__ATOMIC_ACQUIRE, "agent");
            asm volatile("s_waitcnt vmcnt(0)" ::: "memory");
        }
    }
    __syncthreads();
}


__device__ __forceinline__ void p0_prologue(LAS unsigned char* lds, const int tid, const int lane, const int wave, const int gw, const int NGW,
        const float* x, const float* norm_g, const float* w_in, const float* w_co, const float* w_go, const float* w_o,
        bf16* WinT, bf16* WcoT, bf16* WgoT, bf16* WoT, bf16* H, float* GLR) {
    LAS float* wT = (LAS float*)lds;
    LAS float* scr = (LAS float*)(lds + 65536 + wave * 8448);
    for (int idx = tid; idx < 4096; idx += NT) { const int k = idx >> 2, r4 = idx & 3; const f32x4 w = *(const f32x4*)(w_in + (size_t)k * INW + 5120 + 4 * r4);
        wT[(4 * r4 + 0) * 1024 + k] = w[0]; wT[(4 * r4 + 1) * 1024 + k] = w[1]; wT[(4 * r4 + 2) * 1024 + k] = w[2]; wT[(4 * r4 + 3) * 1024 + k] = w[3]; }
    constexpr int I_IN = 16 * 256, I_SQ = 16 * 32, NITEMS = I_IN + 3 * I_SQ;
    for (int it = gw; it < NITEMS; it += NGW) {
        int r = it;
        if (r < I_IN) { const int nb = r >> 4, kb = r & 15; transpose_item(w_in, INW, srcmap(32 * nb), WinT, D, 32 * nb, 64 * kb, scr, lane); continue; } r -= I_IN;
        const float* W = (r < I_SQ) ? w_co : (r < 2 * I_SQ) ? w_go : w_o; bf16* WT = (r < I_SQ) ? WcoT : (r < 2 * I_SQ) ? WgoT : WoT; r &= (I_SQ - 1);
        const int nb = r >> 4, kb = r & 15; transpose_item(W, D, 32 * nb, WT, D, 32 * nb, 64 * kb, scr, lane);
    }
    __syncthreads();
    f32x4 g[4];
#pragma unroll
    for (int j = 0; j < 4; ++j) g[j] = *(const f32x4*)(norm_g + 256 * j + 4 * lane);
    for (int mp = gw; mp < M / 2; mp += NGW) {
        const int m = 2 * mp;
        const f32x4* xr = (const f32x4*)(x + (size_t)m * D) + lane;
        f32x4 v0[4], v1[4]; float s0 = 0.f, s1 = 0.f;
#pragma unroll
        for (int j = 0; j < 4; ++j) { v0[j] = __builtin_nontemporal_load(xr + 64 * j); v1[j] = __builtin_nontemporal_load(xr + 256 + 64 * j);
            s0 += (v0[j][0] * v0[j][0] + v0[j][1] * v0[j][1]) + (v0[j][2] * v0[j][2] + v0[j][3] * v0[j][3]);
            s1 += (v1[j][0] * v1[j][0] + v1[j][1] * v1[j][1]) + (v1[j][2] * v1[j][2] + v1[j][3] * v1[j][3]); }
        const float r0 = 1.0f / sqrtf(wave_sum(s0) * (1.0f / D) + EPS), r1 = 1.0f / sqrtf(wave_sum(s1) * (1.0f / D) + EPS);
        unsigned long long* o8 = (unsigned long long*)(H + (size_t)m * D) + lane;
#pragma unroll
        for (int j = 0; j < 4; ++j) { v0[j] = v0[j] * r0 * g[j]; v1[j] = v1[j] * r1 * g[j];
            o8[64 * j] = (unsigned long long)pk2(v0[j][0], v0[j][1]) | ((unsigned long long)pk2(v0[j][2], v0[j][3]) << 32);
            o8[256 + 64 * j] = (unsigned long long)pk2(v1[j][0], v1[j][1]) | ((unsigned long long)pk2(v1[j][2], v1[j][3]) << 32); }
        float p0[16], p1[16];
#pragma unroll
        for (int r = 0; r < 16; ++r) { float a0 = 0.f, a1 = 0.f;
#pragma unroll
            for (int j = 0; j < 4; ++j) { const f32x4 w = *(const LAS f32x4*)(wT + r * 1024 + 256 * j + 4 * lane);
                a0 += (v0[j][0] * w[0] + v0[j][1] * w[1]) + (v0[j][2] * w[2] + v0[j][3] * w[3]); a1 += (v1[j][0] * w[0] + v1[j][1] * w[1]) + (v1[j][2] * w[2] + v1[j][3] * w[3]); }
            p0[r] = a0; p1[r] = a1; }
        const float t0 = reduce16(p0, lane), t1 = reduce16(p1, lane);
        if ((lane & 3) == 0) { GLR[(size_t)m * 16 + (lane >> 2)] = t0; GLR[(size_t)m * 16 + 16 + (lane >> 2)] = t1; }
    }
}

__device__ __forceinline__ void conv_tile(LAS unsigned char* lds, const int tid, const int lane, const int wave, const int tile,
        const float* conv_w, const float* conv_b, const float* ln_g, const float* ln_b, const bf16* U, const bf16* SZ, bf16* UC) {
    constexpr int TT = 128, GRP = 4;
    LAS float* red = (LAS float*)lds;
    const int c0 = 2 * tid, t0 = tile * TT;
    f32x2 w[CONVK];
#pragma unroll
    for (int j = 0; j < CONVK; ++j) w[j] = *(const f32x2*)(conv_w + j * D + c0);
    const f32x2 cb = *(const f32x2*)(conv_b + c0), lg = *(const f32x2*)(ln_g + c0), lb = *(const f32x2*)(ln_b + c0);
    f32x2 win[CONVK - 1 + GRP];
    const bool seq_start = (t0 % SEQ) == 0;
#pragma unroll
    for (int j = 0; j < CONVK - 1; ++j) {
        unsigned uv = 0u; if (!seq_start) uv = __builtin_nontemporal_load((const unsigned*)(U + (size_t)(t0 - (CONVK - 1) + j) * D + c0));
        win[j] = (f32x2){bflo(uv), bfhi(uv)}; }
    unsigned nxt[GRP], sznxt[GRP];
#pragma unroll
    for (int i = 0; i < GRP; ++i) { nxt[i] = __builtin_nontemporal_load((const unsigned*)(U + (size_t)(t0 + i) * D + c0)); sznxt[i] = __builtin_nontemporal_load((const unsigned*)(SZ + (size_t)(t0 + i) * D + c0)); }
    for (int gi = 0; gi < TT / GRP; ++gi) {
        const int tg = t0 + gi * GRP;
        unsigned szv[GRP];
#pragma unroll
        for (int i = 0; i < GRP; ++i) { win[CONVK - 1 + i] = (f32x2){bflo(nxt[i]), bfhi(nxt[i])}; szv[i] = sznxt[i]; }
        if (gi + 1 < TT / GRP) {
#pragma unroll
            for (int i = 0; i < GRP; ++i) { nxt[i] = __builtin_nontemporal_load((const unsigned*)(U + (size_t)(tg + GRP + i) * D + c0)); sznxt[i] = __builtin_nontemporal_load((const unsigned*)(SZ + (size_t)(tg + GRP + i) * D + c0)); }
        }
        f32x2 cv[GRP]; float st[2 * GRP];
#pragma unroll
        for (int i = 0; i < GRP; ++i) { f32x2 a = cb;
#pragma unroll
            for (int j = 0; j < CONVK; ++j) a = w[j] * win[i + j] + a;
            cv[i] = a; st[2 * i] = a[0] + a[1]; st[2 * i + 1] = a[0] * a[0] + a[1] * a[1]; }
#pragma unroll
        for (int j = 0; j < CONVK - 1; ++j) win[j] = win[j + GRP];
        const float tot = reduce8(st, lane);
        LAS float* rb = red + (gi & 1) * 64;
        if ((lane & 7) == 0) rb[wave * 8 + (lane >> 3)] = tot;
        LDS_BARRIER();
        float pv = rb[lane];
        pv += __shfl_xor(pv, 8); pv += __shfl_xor(pv, 16); pv += __shfl_xor(pv, 32);
#pragma unroll
        for (int i = 0; i < GRP; ++i) {
            const float s1 = __int_as_float(__builtin_amdgcn_readlane(__float_as_int(pv), 2 * i)), s2 = __int_as_float(__builtin_amdgcn_readlane(__float_as_int(pv), 2 * i + 1));
            const float mu = s1 * (1.0f / D), var = fmaxf(s2 * (1.0f / D) - mu * mu, 0.f), rstd = __builtin_amdgcn_rsqf(var + EPS);
            float y0 = (cv[i][0] - mu) * rstd * lg[0] + lb[0], y1 = (cv[i][1] - mu) * rstd * lg[1] + lb[1];
            const float z0 = bflo(szv[i]), z1 = bfhi(szv[i]);
            y0 = y0 * sigm(y0) * (z0 * sigm(z0)); y1 = y1 * sigm(y1) * (z1 * sigm(z1));
            __builtin_nontemporal_store(pk2(y0, y1), (unsigned*)(UC + (size_t)(tg + i) * D + c0));
        }
    }
    LDS_BARRIER();
}

constexpr int S128 = 272, S64 = 144;
constexpr int L_QE = 0, L_KE = 17408, L_QB = 34816, L_KLT = 52224, L_VT = 70656, L_P = 79872, L_ST = 89088, L_GLR = 106496, L_SEG = 110592, L_DEC = 112640;
__device__ __forceinline__ void gla_prepass(LAS unsigned char* L, const int tid, const int lane, const int wave, const int pb, const int h, const int n0, const int nu,
        const float* gate_w2, const float* gate_b, const bf16* Q, const bf16* Kb, const float* GLR, bf16* Pg, bf16* QBg, bf16* KLTg, float* DECg) {
    const int d = tid & 127, seg = tid >> 7, lr = lane & 15, lg = lane >> 4;
    const int qrow0 = tid >> 4, qcu = tid & 15, grow = tid >> 2, gcu = tid & 3;
    u32x4 rq[2], rk[2]; f32x4 rg = (f32x4){0.f, 0.f, 0.f, 0.f};
#define PP_LOAD(u) do { const int h_ = h; const size_t t0_ = (size_t)((u) >> 2) * CHUNK; \
        _Pragma("unroll") for (int i = 0; i < 2; ++i) { rq[i] = __builtin_nontemporal_load((const u32x4*)(Q + (t0_ + qrow0 + 32 * i) * KD + h_ * DK + qcu * 8)); rk[i] = __builtin_nontemporal_load((const u32x4*)(Kb + (t0_ + qrow0 + 32 * i) * KD + h_ * DK + qcu * 8)); } \
        if (tid < 256) rg = __builtin_nontemporal_load((const f32x4*)(GLR + (t0_ + grow) * 16 + gcu * 4)); } while (0)
#define PP_STORE() do { \
        _Pragma("unroll") for (int i = 0; i < 2; ++i) { *(LAS u32x4*)(L + L_QE + (qrow0 + 32 * i) * S128 + qcu * 16) = rq[i]; *(LAS u32x4*)(L + L_KE + (qrow0 + 32 * i) * S128 + qcu * 16) = rk[i]; } \
        if (tid < 256) *(LAS f32x4*)(L + L_GLR + grow * 64 + gcu * 16) = rg; } while (0)
    const int u0 = (pb * NCHUNK + n0) * NH + h;
    float w2[16];
#pragma unroll
    for (int r = 0; r < 16; ++r) w2[r] = gate_w2[r * KD + h * DK + d];
    const float gb = gate_b[h * DK + d];
    PP_LOAD(u0);
    PP_STORE();
    LDS_BARRIER();
    for (int ui = 0; ui < nu; ++ui) {
        const int u = u0 + 4 * ui;
        if (ui + 1 < nu) PP_LOAD(u + 4);
        float bb[16]; float run = 0.f;
#pragma unroll
        for (int i = 0; i < 16; ++i) {
            const LAS f32x4* gp = (const LAS f32x4*)(L + L_GLR + (seg * 16 + i) * 64);
            float z = gb;
#pragma unroll
            for (int r4 = 0; r4 < 4; ++r4) { const f32x4 gv = gp[r4]; z += (gv[0] * w2[4 * r4] + gv[1] * w2[4 * r4 + 1]) + (gv[2] * w2[4 * r4 + 2] + gv[3] * w2[4 * r4 + 3]); }
            const float ls = fminf(z, 0.f) - 0.6931471805599453f * __builtin_amdgcn_logf(1.0f + __expf(-fabsf(z)));
            run += ls * (1.0f / 16.0f); bb[i] = run; }
        ((LAS float*)(L + L_SEG))[seg * 128 + d] = run;
        LDS_BARRIER();
        float offs = 0.f, ref, last;
        { const LAS float* sp = (const LAS float*)(L + L_SEG); const float s0 = sp[d], s1 = sp[128 + d], s2 = sp[256 + d], s3 = sp[384 + d];
          ref = s0 + s1; last = (s0 + s1) + (s2 + s3); offs = (seg == 0) ? 0.f : (seg == 1) ? s0 : (seg == 2) ? (s0 + s1) : (s0 + s1) + s2; }
        unsigned klt[8]; const float eref = __expf(ref), elr = __expf(last - ref);
#pragma unroll
        for (int i = 0; i < 16; ++i) {
            const int t = seg * 16 + i; const float bt = bb[i] + offs;
            LAS unsigned short* qp = (LAS unsigned short*)(L + L_QE + t * S128 + d * 2); LAS unsigned short* kp = (LAS unsigned short*)(L + L_KE + t * S128 + d * 2);
            const float q = bf2f(*qp), k = bf2f(*kp);
            const float e1 = __expf(bt - ref), e2 = __expf(ref - bt), e3 = e1 * eref, e4 = e2 * elr;
            *qp = f2bf(q * e1); *kp = f2bf(k * e2);
            *(LAS unsigned short*)(L + L_QB + t * S128 + d * 2) = f2bf(q * e3);
            const unsigned kl = f2bf(k * e4);
            if (i & 1) klt[i >> 1] |= kl << 16; else klt[i >> 1] = kl; }
        { LAS u32x4* kd = (LAS u32x4*)(L + L_KLT + d * S64 + seg * 32); kd[0] = (u32x4){klt[0], klt[1], klt[2], klt[3]}; kd[1] = (u32x4){klt[4], klt[5], klt[6], klt[7]}; }
        if (seg == 0) DECg[(size_t)u * 128 + d] = __expf(last);
        LDS_BARRIER();
        { const int ti = wave >> 1;
#pragma unroll
          for (int tjj = 0; tjj < 2; ++tjj) { const int tj = 2 * (wave & 1) + tjj; f32x4 a = (f32x4){0.f, 0.f, 0.f, 0.f};
            if (tj <= ti) {
#pragma unroll
                for (int ks = 0; ks < 4; ++ks) { const bf16x8 af = *(const LAS bf16x8*)(L + L_QE + (16 * ti + lr) * S128 + (ks * 32 + 8 * lg) * 2), bfm = *(const LAS bf16x8*)(L + L_KE + (16 * tj + lr) * S128 + (ks * 32 + 8 * lg) * 2);
                    a = __builtin_amdgcn_mfma_f32_16x16x32_bf16(af, bfm, a, 0, 0, 0); } }
            const int jg = 16 * tj + lr;
#pragma unroll
            for (int r = 0; r < 4; ++r) { const int ig = 16 * ti + 4 * lg + r; *(LAS unsigned short*)(L + L_P + ig * S64 + jg * 2) = f2bf((jg <= ig) ? a[r] : 0.f); } } }
        LDS_BARRIER();
        { const int prow = tid >> 3, pcu = tid & 7;
          *(u32x4*)(Pg + (size_t)u * 4096 + prow * 64 + pcu * 8) = *(const LAS u32x4*)(L + L_P + prow * S64 + pcu * 16);
#pragma unroll
          for (int i = 0; i < 2; ++i) { const int idx = tid + 512 * i;
            *(u32x4*)(QBg + (size_t)u * 8192 + (idx >> 4) * 128 + (idx & 15) * 8) = *(const LAS u32x4*)(L + L_QB + (idx >> 4) * S128 + (idx & 15) * 16);
            *(u32x4*)(KLTg + (size_t)u * 8192 + (idx >> 3) * 64 + (idx & 7) * 8) = *(const LAS u32x4*)(L + L_KLT + (idx >> 3) * S64 + (idx & 7) * 16); } }
        if (ui + 1 < nu) PP_STORE();
        LDS_BARRIER();
    }
#undef PP_LOAD
#undef PP_STORE
}

__device__ __forceinline__ void gla_chain(LAS unsigned char* L, const int tid, const int lane, const int wave, const int chain,
        const bf16* V, const bf16* Pg, const bf16* QBg, const bf16* KLTg, const float* DECg, bf16* O, float* SSQP, unsigned* cnt, const float* gn_g, const bf16* SGR, bf16* OG) {
    constexpr int C_P = 0, C_QB = 9216, C_KLT = 26624, C_VT = 45056, C_DEC = 54272, C_BUF = 55296, C_ST = 110592, C_SQ = C_ST + 17408;
    static_assert(C_SQ + 2 * SEQ * 4 <= LDS_MISC, "chain LDS map");
    const int vs = chain & 3, h = (chain >> 2) & 3, b = chain >> 4;
    const int lr = lane & 15, lg = lane >> 4;
    f32x4 stacc[4];
#pragma unroll
    for (int c = 0; c < 4; ++c) stacc[c] = (f32x4){0.f, 0.f, 0.f, 0.f};
    for (int i = tid; i < 17408 / 4; i += NT) ((LAS unsigned*)(L + C_ST))[i] = 0u;
    const int prow = tid >> 3, pcu = tid & 7;
    const int qrow0 = tid >> 4, qcu = tid & 15;
    const size_t tokb = (size_t)b * SEQ;
    LAS float* const sq = (LAS float*)(L + C_SQ);
    u32x4 rp, rqb[2], rkl[2], rv; f32x4 rdec = (f32x4){0.f, 0.f, 0.f, 0.f};
#define CH_LOAD(n) do { const size_t u_ = (size_t)((b * NCHUNK + (n)) * NH + h); \
        rp = __builtin_nontemporal_load((const u32x4*)(Pg + u_ * 4096 + prow * 64 + pcu * 8)); \
        _Pragma("unroll") for (int i = 0; i < 2; ++i) { rqb[i] = __builtin_nontemporal_load((const u32x4*)(QBg + u_ * 8192 + (qrow0 + 32 * i) * 128 + qcu * 8)); rkl[i] = __builtin_nontemporal_load((const u32x4*)(KLTg + u_ * 8192 + (prow + 64 * i) * 64 + pcu * 8)); } \
        rv = __builtin_nontemporal_load((const u32x4*)(V + (tokb + (size_t)(n) * CHUNK + prow) * D + h * DV + vs * 64 + pcu * 8)); \
        rdec = __builtin_nontemporal_load((const f32x4*)(DECg + u_ * 128 + (tid & 31) * 4)); } while (0)
#define CH_STORE(B) do { \
        *(LAS u32x4*)((B) + C_P + prow * S64 + pcu * 16) = rp; \
        _Pragma("unroll") for (int i = 0; i < 2; ++i) { *(LAS u32x4*)((B) + C_QB + (qrow0 + 32 * i) * S128 + qcu * 16) = rqb[i]; *(LAS u32x4*)((B) + C_KLT + (prow + 64 * i) * S64 + pcu * 16) = rkl[i]; } \
        { const unsigned vv[4] = {rv.x, rv.y, rv.z, rv.w}; \
          _Pragma("unroll") for (int e = 0; e < 4; ++e) { *(LAS unsigned short*)((B) + C_VT + (pcu * 8 + 2 * e) * S64 + prow * 2) = (unsigned short)(vv[e] & 0xffffu); \
                                                         *(LAS unsigned short*)((B) + C_VT + (pcu * 8 + 2 * e + 1) * S64 + prow * 2) = (unsigned short)(vv[e] >> 16); } } \
        *(LAS f32x4*)((B) + C_DEC + (tid & 31) * 16) = rdec; } while (0)
    CH_LOAD(0);
    CH_STORE(L);
    CH_LOAD(1);
    __syncthreads();
    for (int n = 0; n < NCHUNK; ++n) {
        LAS unsigned char* const Bc = L + (n & 1) * C_BUF; LAS unsigned char* const Bn = L + ((n & 1) ^ 1) * C_BUF;
        LAS unsigned char* const Sc = L + C_ST;
        const size_t tok0 = tokb + (size_t)n * CHUNK;
        if (n + 1 < NCHUNK) { CH_STORE(Bn); if (n + 2 < NCHUNK) CH_LOAD(n + 2); }
        { const int ti = wave & 3, tv0 = 2 * (wave >> 2); f32x4 a0 = (f32x4){0.f, 0.f, 0.f, 0.f}, a1 = a0;
#pragma unroll
          for (int ks = 0; ks < 2; ++ks) { const bf16x8 af = *(const LAS bf16x8*)(Bc + C_P + (16 * ti + lr) * S64 + (ks * 32 + 8 * lg) * 2);
            const bf16x8 b0 = *(const LAS bf16x8*)(Bc + C_VT + (16 * tv0 + lr) * S64 + (ks * 32 + 8 * lg) * 2), b1 = *(const LAS bf16x8*)(Bc + C_VT + (16 * tv0 + 16 + lr) * S64 + (ks * 32 + 8 * lg) * 2);
            a0 = __builtin_amdgcn_mfma_f32_16x16x32_bf16(b0, af, a0, 0, 0, 0); a1 = __builtin_amdgcn_mfma_f32_16x16x32_bf16(b1, af, a1, 0, 0, 0); }
#pragma unroll
          for (int ks = 0; ks < 4; ++ks) { const bf16x8 af = *(const LAS bf16x8*)(Bc + C_QB + (16 * ti + lr) * S128 + (ks * 32 + 8 * lg) * 2);
            const bf16x8 b0 = *(const LAS bf16x8*)(Sc + (16 * tv0 + lr) * S128 + (ks * 32 + 8 * lg) * 2), b1 = *(const LAS bf16x8*)(Sc + (16 * tv0 + 16 + lr) * S128 + (ks * 32 + 8 * lg) * 2);
            a0 = __builtin_amdgcn_mfma_f32_16x16x32_bf16(b0, af, a0, 0, 0, 0); a1 = __builtin_amdgcn_mfma_f32_16x16x32_bf16(b1, af, a1, 0, 0, 0); }
          { bf16* op = O + (tok0 + 16 * ti + lr) * D + h * DV + vs * 64 + 16 * tv0 + 4 * lg;
            u32x2 w0, w1; w0.x = (unsigned)f2bf(a0[0]) | ((unsigned)f2bf(a0[1]) << 16); w0.y = (unsigned)f2bf(a0[2]) | ((unsigned)f2bf(a0[3]) << 16);
            w1.x = (unsigned)f2bf(a1[0]) | ((unsigned)f2bf(a1[1]) << 16); w1.y = (unsigned)f2bf(a1[2]) | ((unsigned)f2bf(a1[3]) << 16);
            *(u32x2*)op = w0; *(u32x2*)(op + 16) = w1; }
          { float s_ = ((a0[0] * a0[0] + a0[1] * a0[1]) + (a0[2] * a0[2] + a0[3] * a0[3])) + ((a1[0] * a1[0] + a1[1] * a1[1]) + (a1[2] * a1[2] + a1[3] * a1[3]));
            s_ += __shfl_xor(s_, 16); s_ += __shfl_xor(s_, 32);
            if (lg == 0) sq[(wave >> 2) * SEQ + n * CHUNK + 16 * ti + lr] = s_; } }
        { const int tv = wave & 3; bf16x8 vf[2];
#pragma unroll
          for (int ks = 0; ks < 2; ++ks) vf[ks] = *(const LAS bf16x8*)(Bc + C_VT + (16 * tv + lr) * S64 + (ks * 32 + 8 * lg) * 2);
#pragma unroll
          for (int c = 0; c < 4; ++c) { const int td = (wave >> 2) * 4 + c; const f32x4 dec4 = *(const LAS f32x4*)(Bc + C_DEC + (16 * td + 4 * lg) * 4);
            f32x4 a = stacc[c] * dec4;
#pragma unroll
            for (int ks = 0; ks < 2; ++ks) { const bf16x8 kf = *(const LAS bf16x8*)(Bc + C_KLT + (16 * td + lr) * S64 + (ks * 32 + 8 * lg) * 2);
                a = __builtin_amdgcn_mfma_f32_16x16x32_bf16(kf, vf[ks], a, 0, 0, 0); }
            stacc[c] = a; } }
        LDS_BARRIER();
        if (n + 1 < NCHUNK) { const int tv = wave & 3;
#pragma unroll
          for (int c = 0; c < 4; ++c) { const int td = (wave >> 2) * 4 + c; u32x2 w; w.x = (unsigned)f2bf(stacc[c][0]) | ((unsigned)f2bf(stacc[c][1]) << 16); w.y = (unsigned)f2bf(stacc[c][2]) | ((unsigned)f2bf(stacc[c][3]) << 16);
            *(LAS u32x2*)(Sc + (16 * tv + lr) * S128 + (16 * td + 4 * lg) * 2) = w; } }
        LDS_BARRIER();
    }
#undef CH_LOAD
#undef CH_STORE
#pragma unroll
    for (int j = 0; j < SEQ / NT; ++j) { const int t = tid + NT * j;
        const unsigned long long pr = (unsigned long long)__float_as_uint(sq[t]) | ((unsigned long long)__float_as_uint(sq[SEQ + t]) << 32);
        __hip_atomic_store((unsigned long long*)(SSQP + ((size_t)(h * 4 + vs) * M + tokb + t) * 2), pr, __ATOMIC_RELAXED, __HIP_MEMORY_SCOPE_AGENT); }
    asm volatile("s_waitcnt vmcnt(0)" ::: "memory");
    __syncthreads();
    if (tid == 0) {
        unsigned* c = cnt + (b * NH + h) * 64;
        (void)__hip_atomic_fetch_add(c, 1u, __ATOMIC_RELAXED, __HIP_MEMORY_SCOPE_AGENT);
        unsigned spins = 0;
        while (__hip_atomic_load(c, __ATOMIC_RELAXED, __HIP_MEMORY_SCOPE_AGENT) < 4u) { __builtin_amdgcn_s_sleep(2); if (++spins > (1u << 24)) break; }
    }
    __syncthreads();
    { LAS float* rt = (LAS float*)L;
#pragma unroll
      for (int j = 0; j < SEQ / NT; ++j) { const int t = tid + NT * j; float ssq = 0.f;
#pragma unroll
        for (int v4 = 0; v4 < 4; ++v4) { const float* sp = SSQP + ((size_t)(h * 4 + v4) * M + tokb + t) * 2;
            ssq += __hip_atomic_load(sp, __ATOMIC_RELAXED, __HIP_MEMORY_SCOPE_AGENT) + __hip_atomic_load(sp + 1, __ATOMIC_RELAXED, __HIP_MEMORY_SCOPE_AGENT); }
        rt[t] = 1.0f / sqrtf(ssq * (1.0f / DV) + EPS); }
      __syncthreads();
      const int c8 = (tid & 7) * 8, colh = vs * 64 + c8;
      const f32x4 g0 = *(const f32x4*)(gn_g + colh), g1 = *(const f32x4*)(gn_g + colh + 4);
      for (int pass0 = 0; pass0 < SEQ / 64; pass0 += 8) {
        u32x4 ov[8], sgv[8];
#pragma unroll
        for (int j = 0; j < 8; ++j) { const size_t off = (tokb + (pass0 + j) * 64 + (tid >> 3)) * D + h * DV + colh; ov[j] = __builtin_nontemporal_load((const u32x4*)(O + off)); sgv[j] = __builtin_nontemporal_load((const u32x4*)(SGR + off)); }
#pragma unroll
        for (int j = 0; j < 8; ++j) { const int t = (pass0 + j) * 64 + (tid >> 3); const size_t off = (tokb + t) * D + h * DV + colh;
            const float rstd = rt[t];
            const u32x4 o = ov[j], sg = sgv[j]; u32x4 w;
            const float q0 = bflo(sg.x), q1 = bfhi(sg.x), q2 = bflo(sg.y), q3 = bfhi(sg.y), q4 = bflo(sg.z), q5 = bfhi(sg.z), q6 = bflo(sg.w), q7 = bfhi(sg.w);
            w.x = pk2(bflo(o.x) * rstd * g0[0] * (q0 * sigm(q0)), bfhi(o.x) * rstd * g0[1] * (q1 * sigm(q1)));
            w.y = pk2(bflo(o.y) * rstd * g0[2] * (q2 * sigm(q2)), bfhi(o.y) * rstd * g0[3] * (q3 * sigm(q3)));
            w.z = pk2(bflo(o.z) * rstd * g1[0] * (q4 * sigm(q4)), bfhi(o.z) * rstd * g1[1] * (q5 * sigm(q5)));
            w.w = pk2(bflo(o.w) * rstd * g1[2] * (q6 * sigm(q6)), bfhi(o.w) * rstd * g1[3] * (q7 * sigm(q7)));
            __builtin_nontemporal_store(w, (u32x4*)(OG + off)); }
      }
      __syncthreads(); }
}

__device__ __forceinline__ void final_rows(const int lane, const int gw, const int NGW, const float* final_g, const float* ROWSS, float* out) {
    f32x4 g[4];
#pragma unroll
    for (int j = 0; j < 4; ++j) g[j] = *(const f32x4*)(final_g + 256 * j + 4 * lane);
    for (int m = gw; m < M; m += NGW) {
        float ssq = 0.f;
#pragma unroll
        for (int j = 0; j < 4; ++j) { const f32x4 p = *(const f32x4*)(ROWSS + ((size_t)j * M + m) * 4); ssq += (p[0] + p[1]) + (p[2] + p[3]); }
        const float rstd = 1.0f / sqrtf(ssq * (1.0f / D) + EPS);
        f32x4* xr = (f32x4*)(out + (size_t)m * D) + lane;
#pragma unroll
        for (int j = 0; j < 4; ++j) { const f32x4 v = xr[64 * j]; xr[64 * j] = v * rstd * g[j]; }
    }
}

__global__ void __launch_bounds__(NT, 2) fwd_megakernel(Args args) {
    extern __shared__ __attribute__((aligned(16))) unsigned char lds[];
    cg::grid_group grid = cg::this_grid();
#define GRID_SYNC() do { asm volatile("s_waitcnt vmcnt(0)" ::: "memory"); grid.sync(); asm volatile("buffer_inv sc1\n\ts_waitcnt vmcnt(0)" ::: "memory"); } while (0)
    LAS unsigned char* const L = (LAS unsigned char*)lds;
    const int tid = threadIdx.x, lane = tid & 63, wave = __builtin_amdgcn_readfirstlane(tid >> 6);
    const int G = gridDim.x; int bx = blockIdx.x, vcu = (G % 8 == 0) ? (bx % 8) * (G / 8) + bx / 8 : bx;
    int gw = vcu * NWAVES + wave; const int NGW = G * NWAVES;
    unsigned char* const ws = args.ws; unsigned char* const ob = (unsigned char*)args.out;
    if (tid < 4) ((LAS unsigned*)(L + LDS_MISC))[tid] = 0u;
    __syncthreads();
    const XcdBarrier xbar = xcd_barrier_post((unsigned*)(ws + WS_CTL), (volatile LAS unsigned*)(L + LDS_MISC));
#define XCD_SYNC() xcd_barrier(xbar)
#define P_WIN  ((bf16*)(ws + WS_WIN))
#define P_WCO  ((bf16*)(ws + WS_WCO))
#define P_WGO  ((bf16*)(ws + WS_WGO))
#define P_WO   ((bf16*)(ws + WS_WO))
#define P_GLR  ((float*)(ws + WS_GLR))
#define P_SSQP ((float*)(ws + WS_SSQP))
#define P_ROWSS ((float*)(ws + WS_ROWSS))
#ifndef P_H
#define P_H    ((bf16*)ob)
#endif
#define P_UC   ((bf16*)ob)
#define P_U    ((bf16*)(ob + 64 * MiB))
#define P_SZ   ((bf16*)(ws + WS_SZ))
#define P_YCM  ((bf16*)(ws + WS_Q))
#define P_Q    ((bf16*)(ws + WS_Q))
#define P_K    ((bf16*)(ws + WS_K))
#define P_Y    ((bf16*)(ws + WS_V))
#define P_V    ((bf16*)(ws + WS_V))
#define P_OG   ((bf16*)(ob + 64 * MiB))
#define P_SGR  ((bf16*)(ws + WS_SGR))
#define P_MC   ((bf16*)(ws + WS_MC))
#define P_MG   ((bf16*)(ws + WS_MG))
#define P_O    ((bf16*)(ws + WS_SZ))
#define P_PP   ((bf16*)(ws + WS_PP))
#define P_PQB  ((bf16*)(ws + WS_PQB))
#define P_PKLT ((bf16*)(ws + WS_PKLT))
#define P_PDEC ((float*)(ws + WS_PDEC))
#define P_CNT  ((unsigned*)(ws + WS_CNT))
#define P_CNT2 ((unsigned*)(ws + WS_CNT + 32768))

    const int lo = args.ph_lo, hi = args.ph_hi;
#define IN(k) (lo <= (k) && (k) < hi)
#define SEAM(k) do { if (IN(k) && IN((k) + 1)) { if (args.ph_hi > 1000) GRID_SYNC(); else XCD_SYNC(); } } while (0)
#ifndef REP_PHASE
#define REP_PHASE -1
#endif
#define REP(k) (REP_PHASE == (k) ? 2 : 1)
#define RUN_P0() do { \
    p0_prologue(L, tid, lane, wave, gw, NGW, args.in[0], args.in[1], args.in[2], args.in[7], args.in[11], args.in[12], P_WIN, P_WCO, P_WGO, P_WO, P_H, P_GLR); } while (0)
#define RUN_P1() do { pg8::Gemm g{P_H, P_WIN, M, NPROJ, D}; pg8::StaticOrder S; S.init(M, NPROJ, G, bx); EpiProj E{P_U, ws}; \
    pg8::gemm_phase<EpiProj, pg8::StaticOrder, PG8_ALIGN, PG8_SP2>(L, g, S, E); } while (0)
#define RUN_P2() do { \
    for (int t = vcu; t < M / 128; t += G) conv_tile(L, tid, lane, wave, t, args.in[3], args.in[4], args.in[5], args.in[6], P_U, P_SZ, P_UC); \
    {   \
      for (int v = vcu; v < BATCH * NH * 4; v += G) gla_prepass(L, tid, lane, wave, v >> 4, (v >> 2) & 3, (v & 3) * (NCHUNK / 4), NCHUNK / 4, args.in[8], args.in[9], P_Q, P_K, P_GLR, P_PP, P_PQB, P_PKLT, P_PDEC); } } while (0)
#define RUN_P3() do { \
    for (int c = vcu; c < BATCH * NH * 4; c += G) gla_chain(L, tid, lane, wave, c, P_V, P_PP, P_PQB, P_PKLT, P_PDEC, P_O, P_SSQP, P_CNT, args.in[10], P_SGR, P_OG); } while (0)
#define RUN_P4() do { pg8::Gemm g{P_UC, P_WCO, 2 * M, 2 * D, D}; BranchOrder S; S.init(G, bx); EpiBranches E{P_Y, P_YCM, P_MC, P_MG}; \
    pg8::gemm_phase<EpiBranches, BranchOrder, PG8_ALIGN, PG8_SP2>(L, g, S, E); } while (0)
#define RUN_P5() do { pg8::Gemm g{P_Y, P_WO, M, D, D}; EpiResNorm E{args.out, args.in[0], args.in[13], P_ROWSS, P_CNT2}; \
    _Pragma("unroll 1") for (int hf = 0; hf < 2; ++hf) { HalfOrder S; S.init(M / 2, D, G, bx); S.pmoff = hf * (M / 512); \
      pg8::gemm_phase<EpiResNorm, HalfOrder, false, PG8_SP2>(L, g, S, E); } } while (0)
#define RUN_P6() do { } while (0)

    if (IN(0)) RUN_P0();
#if REP_PHASE == 0
    XCD_SYNC(); RUN_P0();
#endif
    SEAM(0);
    if (IN(0) && IN(1)) {
        volatile LAS unsigned* ms = (volatile LAS unsigned*)(L + LDS_MISC);
        if (tid == 0) { unsigned* bar = (unsigned*)(ws + WS_CTL); unsigned pop = 0u, below = 0u; bool ok = (G % 8 == 0);
            for (unsigned j = 0; j < 16; ++j) { const unsigned cj = xb_ld(&bar[XB_XCNT(j)]); if (cj) { ++pop; if (j < xbar.x) ++below; if (cj != (unsigned)(G / 8)) ok = false; } }
            ok = ok && pop == 8u && ms[2] < (unsigned)(G / 8);
            ms[3] = ok ? (below + 8u * ms[2]) : (unsigned)blockIdx.x; }
        __syncthreads();
        bx = __builtin_amdgcn_readfirstlane((int)ms[3]); vcu = (G % 8 == 0) ? (bx % 8) * (G / 8) + bx / 8 : bx; gw = vcu * NWAVES + wave;
    }
    if (IN(1)) RUN_P1();
#if REP_PHASE == 1
    XCD_SYNC(); RUN_P1();
#endif
    SEAM(1);
    if (IN(2)) RUN_P2();
#if REP_PHASE == 2
    XCD_SYNC(); RUN_P2();
#endif
    SEAM(2);
    if (IN(3)) RUN_P3();
#if REP_PHASE == 3
    XCD_SYNC(); RUN_P3();
#endif
    SEAM(3);
    if (IN(4)) RUN_P4();
#if REP_PHASE == 4
    XCD_SYNC(); RUN_P4();
#endif
    SEAM(4);
    if (IN(5)) RUN_P5();
#if REP_PHASE == 5
    XCD_SYNC(); RUN_P5();
#endif
#ifdef DUMP_SRC
    if (IN(7)) { const bf16* src = DUMP_SRC;
#ifndef DUMP_ROWS
#define DUMP_ROWS M
#endif
        for (int m = gw; m < M; m += NGW) { u32x4 a = (u32x4){0u, 0u, 0u, 0u}, b = a; if (m < DUMP_ROWS) { a = *(const u32x4*)(src + (size_t)m * D + 8 * lane); b = *(const u32x4*)(src + (size_t)m * D + 512 + 8 * lane); }
            float* o = args.out + (size_t)m * D + 8 * lane;
            *(f32x4*)(o) = (f32x4){bflo(a.x), bfhi(a.x), bflo(a.y), bfhi(a.y)}; *(f32x4*)(o + 4) = (f32x4){bflo(a.z), bfhi(a.z), bflo(a.w), bfhi(a.w)};
            *(f32x4*)(o + 512) = (f32x4){bflo(b.x), bfhi(b.x), bflo(b.y), bfhi(b.y)}; *(f32x4*)(o + 516) = (f32x4){bflo(b.z), bfhi(b.z), bflo(b.w), bfhi(b.w)}; } }
#endif
}

extern "C" void kernel_launch(void* const* d_in, const int* in_sizes, int n_in, void* d_out, int out_size, void* d_ws, size_t ws_size, hipStream_t stream) {
    static int grid = 0;
    if (grid == 0) {
        if (n_in != 14 || in_sizes[0] != M * D || out_size != M * D || ws_size < WS_END) { fprintf(stderr, "kernel_launch: unexpected shapes (n_in %d, in0 %d, out %d, ws %zu)\n", n_in, n_in > 0 ? in_sizes[0] : -1, out_size, ws_size); grid = -1; return; }
        int dev = 0, cus = 0, per_cu = 0;
        if (hipGetDevice(&dev) != hipSuccess || hipDeviceGetAttribute(&cus, hipDeviceAttributeMultiprocessorCount, dev) != hipSuccess) { grid = -1; return; }
        if (hipFuncSetAttribute((const void*)fwd_megakernel, hipFuncAttributeMaxDynamicSharedMemorySize, LDS_BYTES) != hipSuccess) { fprintf(stderr, "kernel_launch: hipFuncSetAttribute failed\n"); grid = -1; return; }
        if (hipOccupancyMaxActiveBlocksPerMultiprocessor(&per_cu, (const void*)fwd_megakernel, NT, LDS_BYTES) != hipSuccess || per_cu < 1) { fprintf(stderr, "kernel_launch: occupancy query says %d\n", per_cu); per_cu = 1; }
        (void)hipGetLastError();
        grid = cus;
        if (grid != 256) fprintf(stderr, "kernel_launch: note: %d CUs (built for 256: the GLA chains expect one chain per workgroup)\n", grid);
    }
    if (grid < 0) return;
    if (hipMemsetAsync((char*)d_ws + WS_CTL, 0, CTL_ZERO_BYTES, stream) != hipSuccess) { fprintf(stderr, "kernel_launch: hipMemsetAsync failed\n"); return; }
    Args a{};
    for (int i = 0; i < 14; ++i) a.in[i] = (const float*)d_in[i];
    a.out = (float*)d_out; a.ws = (unsigned char*)d_ws;
    void* kargs[] = {&a};
    for (int li = 0; li < MK_N_LAUNCHES + MK_DUMP; ++li) {
#ifdef MK_LAST_PHASE
        if (li >= MK_LAST_PHASE && li < 7) continue;
#endif
        a.ph_lo = (MK_N_LAUNCHES == 1) ? 0 : li; a.ph_hi = (MK_N_LAUNCHES == 1) ? 6 : li + 1;
        const hipError_t e = hipLaunchCooperativeKernel((const void*)fwd_megakernel, dim3(grid), dim3(NT), kargs, LDS_BYTES, stream);
        if (e != hipSuccess) fprintf(stderr, "kernel_launch: cooperative launch failed: %s (grid %d)\n", hipGetErrorString(e), grid);
    }
}
```
